# Optimizing an MI355X kernel written in HIP

```python
import math
import jax, jax.numpy as jnp
from jax import lax
import numpy as np

D_MODEL = 2048
BATCH = 16
SEQ = 2048
DEPTH = 4

N_A_LAYERS = DEPTH // 2
N_B_LAYERS = DEPTH - N_A_LAYERS
HEAD_DIM = 128
N_HEADS = D_MODEL // HEAD_DIM
N_KV_A = 4
GROUP_A = N_HEADS // N_KV_A
IDX_HEADS = 16
IDX_DIM = 64
INDEX_TOPK = 256
PLE_DIM = 256
ROPE_THETA = 10000.0
A_BLOCK = 64
B_BLOCK = 128
LN_EPS = 1e-5
DN_ALPHA = (2 * DEPTH) ** 0.25
DN_BETA = (8 * DEPTH) ** -0.25
ATTN_W = N_HEADS * HEAD_DIM
KV_W_A = N_KV_A * HEAD_DIM
A_SPLITS = (ATTN_W, KV_W_A, KV_W_A, ATTN_W, IDX_HEADS * IDX_DIM, IDX_HEADS, IDX_DIM)
A_IN_WIDTH = sum(A_SPLITS)
NEG_BIG = -1e30

kernel_name = "yoco_dsa_stickbreaking_hybrid"


def _split(h, sizes):
    idx, acc = [], 0
    for s in sizes[:-1]:
        acc += s
        idx.append(acc)
    return jnp.split(h, idx, axis=-1)


def _layer_norm(x, g, b):
    xf = x.astype(jnp.float32)
    mu = jnp.mean(xf, axis=-1, keepdims=True)
    var = jnp.mean(jnp.square(xf - mu), axis=-1, keepdims=True)
    y = (xf - mu) * lax.rsqrt(var + LN_EPS) * g.astype(jnp.float32) + b.astype(jnp.float32)
    return y.astype(x.dtype)


def _rope(x, pos):
    half = x.shape[-1] // 2
    inv = ROPE_THETA ** (-jnp.arange(half, dtype=jnp.float32) / half)
    ang = pos.astype(jnp.float32)[..., None] * inv
    cos = jnp.cos(ang)[:, :, None, :]
    sin = jnp.sin(ang)[:, :, None, :]
    xf = x.astype(jnp.float32)
    x1, x2 = xf[..., :half], xf[..., half:]
    return jnp.concatenate([x1 * cos - x2 * sin, x2 * cos + x1 * sin], axis=-1).astype(x.dtype)


def _to_blocks(a, blk):
    b, s = a.shape[0], a.shape[1]
    return a.reshape(b, s // blk, blk, *a.shape[2:]).swapaxes(0, 1)


def _dsa_mixer(x, pos, w_in, w_out):
    B, S, _ = x.shape
    h = x @ w_in
    q, k, v, g, qi, wi, ki = _split(h, A_SPLITS)
    q = _rope(q.reshape(B, S, N_HEADS, HEAD_DIM), pos)
    k = _rope(k.reshape(B, S, N_KV_A, HEAD_DIM), pos)
    v = v.reshape(B, S, N_KV_A, HEAD_DIM)
    qi = _rope(qi.reshape(B, S, IDX_HEADS, IDX_DIM), pos)
    ki = _rope(ki.reshape(B, S, 1, IDX_DIM), pos)[:, :, 0]
    wi = wi.astype(jnp.float32) * (IDX_HEADS ** -0.5 * IDX_DIM ** -0.5)
    k_top = min(INDEX_TOPK, S // 4)
    n_blk = S // A_BLOCK
    key_pos = jnp.arange(S)
    scale = HEAD_DIM ** -0.5

    def block(args):
        i, qb, qib, wib = args
        t = i * A_BLOCK + jnp.arange(A_BLOCK)
        dots = jnp.einsum('bqhd,bsd->bqhs', qib, ki, preferred_element_type=jnp.float32)
        score = jnp.einsum('bqhs,bqh->bqs', jax.nn.relu(dots), wib)
        causal = key_pos[None, :] <= t[:, None]
        score = jnp.where(causal[None], score, NEG_BIG)
        _, sel = lax.top_k(score, k_top)
        valid = sel <= t[None, :, None]
        ks = jax.vmap(lambda kb, ib: kb[ib])(k, sel)
        vs = jax.vmap(lambda vb, ib: vb[ib])(v, sel)
        qg = qb.reshape(B, A_BLOCK, N_KV_A, GROUP_A, HEAD_DIM)
        s = jnp.einsum('bqgrd,bqkgd->bqgrk', qg, ks, preferred_element_type=jnp.float32) * scale
        s = jnp.where(valid[:, :, None, None, :], s, -jnp.inf)
        pr = jax.nn.softmax(s, axis=-1).astype(vs.dtype)
        o = jnp.einsum('bqgrk,bqkgd->bqgrd', pr, vs)
        return o.reshape(B, A_BLOCK, ATTN_W)

    o = lax.map(block, (jnp.arange(n_blk), _to_blocks(q, A_BLOCK),
                        _to_blocks(qi, A_BLOCK), _to_blocks(wi, A_BLOCK)))
    o = o.swapaxes(0, 1).reshape(B, S, ATTN_W)
    return (o * jax.nn.silu(g)) @ w_out


def _stick_breaking_mixer(x, k, v, w_q, w_out):
    B, S, _ = x.shape
    q, g = _split(x @ w_q, (ATTN_W, ATTN_W))
    q = q.reshape(B, S, N_HEADS, HEAD_DIM)
    n_blk = S // B_BLOCK
    key_pos = jnp.arange(S)
    scale = HEAD_DIM ** -0.5

    def block(args):
        i, qb = args
        t = i * B_BLOCK + jnp.arange(B_BLOCK)
        z = jnp.einsum('bqhd,bshd->bhqs', qb, k, preferred_element_type=jnp.float32) * scale
        strict = (key_pos[None, :] < t[:, None])[None, None]
        log_keep = jnp.where(strict, jax.nn.log_sigmoid(-z), 0.0)
        between = lax.cumsum(log_keep, axis=3, reverse=True) - log_keep
        a = jnp.where(strict, jnp.exp(jax.nn.log_sigmoid(z) + between), 0.0)
        o = jnp.einsum('bhqs,bshd->bqhd', a.astype(v.dtype), v)
        return o.reshape(B, B_BLOCK, ATTN_W)

    o = lax.map(block, (jnp.arange(n_blk), _to_blocks(q, B_BLOCK)))
    o = o.swapaxes(0, 1).reshape(B, S, ATTN_W)
    return (o * jax.nn.silu(g)) @ w_out


def setup_inputs(seed: int = 0) -> dict:
    key = jax.random.key(seed)
    ks = jax.random.split(key, 14)
    f32 = jnp.float32
    d_in = D_MODEL ** -0.5
    x = jax.random.normal(ks[0], (BATCH, SEQ, D_MODEL), f32)
    p = jax.random.normal(ks[1], (DEPTH, BATCH, SEQ, PLE_DIM), f32)
    offs = jax.random.randint(ks[2], (BATCH, 1), 0, 4096, dtype=jnp.int32)
    positions = (offs + jnp.arange(SEQ, dtype=jnp.int32)[None, :]).astype(jnp.int32)
    w_in_a = jax.random.normal(ks[3], (N_A_LAYERS, D_MODEL, A_IN_WIDTH), f32) * d_in
    w_out_a = jax.random.normal(ks[4], (N_A_LAYERS, ATTN_W, D_MODEL), f32) * (ATTN_W ** -0.5 * DN_BETA)
    w_q_b = jax.random.normal(ks[5], (N_B_LAYERS, D_MODEL, 2 * ATTN_W), f32) * d_in
    w_kv_b = jax.random.normal(ks[6], (D_MODEL, 2 * ATTN_W), f32) * d_in
    w_out_b = jax.random.normal(ks[7], (N_B_LAYERS, ATTN_W, D_MODEL), f32) * (ATTN_W ** -0.5 * DN_BETA)
    ln_g = 1.0 + 0.02 * jax.random.normal(ks[8], (DEPTH, D_MODEL), f32)
    ln_b = 0.02 * jax.random.normal(ks[9], (DEPTH, D_MODEL), f32)
    w_ple = jax.random.normal(ks[10], (DEPTH, PLE_DIM, D_MODEL), f32) * PLE_DIM ** -0.5
    w_ple_gate = jax.random.normal(ks[11], (DEPTH, D_MODEL, D_MODEL), f32) * d_in
    return {"x": x, "p": p, "positions": positions,
            "w_in_a": w_in_a, "w_out_a": w_out_a,
            "w_q_b": w_q_b, "w_kv_b": w_kv_b, "w_out_b": w_out_b,
            "ln_g": ln_g, "ln_b": ln_b, "w_ple": w_ple, "w_ple_gate": w_ple_gate}


def reference(x, p, positions, w_in_a, w_out_a, w_q_b, w_kv_b, w_out_b,
              ln_g, ln_b, w_ple, w_ple_gate):
    B, S, _ = x.shape
    k_b = None
    v_b = None
    for i in range(DEPTH):
        if i < N_A_LAYERS:
            y = _dsa_mixer(x, positions, w_in_a[i], w_out_a[i])
        else:
            j = i - N_A_LAYERS
            y = _stick_breaking_mixer(x, k_b, v_b, w_q_b[j], w_out_b[j])
        x = _layer_norm(DN_ALPHA * x + y, ln_g[i], ln_b[i])
        x = x + (p[i] @ w_ple[i]) * jax.nn.sigmoid(x @ w_ple_gate[i])
        if i == N_A_LAYERS - 1:
            kb, vb = _split(x @ w_kv_b, (ATTN_W, ATTN_W))
            k_b = kb.reshape(B, S, N_HEADS, HEAD_DIM)
            v_b = vb.reshape(B, S, N_HEADS, HEAD_DIM)
    return x
```

```cpp
#include <hip/hip_runtime.h>
#include <hip/hip_cooperative_groups.h>
#include <cstdio>
#include <cstdint>
namespace cg = cooperative_groups;

#ifndef DBG_YMUL_A
#define DBG_YMUL_A 1.0f
#endif
#ifndef DBG_YMUL_B
#define DBG_YMUL_B 1.0f
#endif

#ifndef PROBE_REPEAT_KIND
#define PROBE_REPEAT_KIND (-1)
#endif
#ifndef PROBE_SCORE_REPS
#define PROBE_SCORE_REPS 1
#endif
#ifndef PROBE_SEL_REPS
#define PROBE_SEL_REPS 1
#endif
#ifndef PROBE_EXTRA_SYNCS
#define PROBE_EXTRA_SYNCS 0
#endif
#define LAS __attribute__((address_space(3)))
#define GAS __attribute__((address_space(1)))
typedef unsigned short bf16_t;
typedef short bf16x8 __attribute__((ext_vector_type(8)));
typedef float f32x4 __attribute__((ext_vector_type(4)));
typedef float f32x2 __attribute__((ext_vector_type(2)));
typedef float f32x16 __attribute__((ext_vector_type(16)));
typedef unsigned u32x4 __attribute__((ext_vector_type(4)));
typedef unsigned u32x2 __attribute__((ext_vector_type(2)));

constexpr int DM = 2048, NB = 16, SEQ = 2048, T = NB * SEQ, HD = 128, PLE = 256;
constexpr int AW = 6224;
constexpr int AWP = 6400;
constexpr int ANP = 5888;
constexpr float LN_EPS = 1e-5f;
constexpr float DN_ALPHA = 1.6817928305074290f;
constexpr float QSCALE = 0.08838834764831845f;
constexpr float LOG2E = 1.4426950408889634f;
constexpr int NWAVES = 8, NTHREADS = 512;

constexpr size_t MiB = 1u << 20;
constexpr size_t WS_WINA = 0;
constexpr size_t WS_WOUTA = 50 * MiB;
constexpr size_t WS_WQB = 66 * MiB;
constexpr size_t WS_WKV = 98 * MiB;
constexpr size_t WS_WOUTB = 114 * MiB;
constexpr size_t WS_WPLE = 130 * MiB;
constexpr size_t WS_WG = 134 * MiB;
constexpr size_t WS_XB1 = 166 * MiB;
constexpr size_t WS_XB2 = 294 * MiB;
constexpr size_t WS_QO = 422 * MiB;
constexpr size_t WS_SGP = 550 * MiB;
constexpr size_t WS_QI = 678 * MiB;
constexpr size_t WS_KA = 742 * MiB;
constexpr size_t WS_VTA = 774 * MiB;
constexpr size_t WS_KB = WS_QI;
constexpr size_t WS_KI = 806 * MiB;
constexpr size_t WS_WI = 810 * MiB;
constexpr size_t WS_MB = 812 * MiB;
constexpr size_t WS_VTB = 820 * MiB;
constexpr size_t WS_CS128 = 948 * MiB;
constexpr size_t WS_CS64 = 964 * MiB;
constexpr size_t WS_PBF = 972 * MiB;
constexpr size_t WS_BAR = 988 * MiB;
constexpr size_t WS_STATS = 988 * MiB + 65536;
constexpr size_t WS_LNP = WS_STATS + 1 * MiB;
constexpr size_t WS_GPART = WS_LNP + 131072;
constexpr size_t WS_END = 991 * MiB;

constexpr int LDS_BYTES = 147456, LDS_BARST = 131072 + 256;

__device__ const float ROPE_INV[64] = {
1.000000000e+00f, 8.659643531e-01f, 7.498942614e-01f, 6.493816376e-01f, 5.623413324e-01f, 4.869675338e-01f, 4.216965139e-01f, 3.651741147e-01f, 3.162277639e-01f, 2.738419771e-01f, 2.371373773e-01f, 2.053525001e-01f, 1.778279394e-01f, 1.539926529e-01f, 1.333521307e-01f, 1.154782027e-01f, 1.000000015e-01f, 8.659642935e-02f, 7.498941571e-02f, 6.493816525e-02f, 5.623413250e-02f, 4.869675264e-02f, 4.216965288e-02f, 3.651741147e-02f, 3.162277490e-02f, 2.738419734e-02f, 2.371373773e-02f, 2.053525113e-02f, 1.778279431e-02f, 1.539926510e-02f, 1.333521493e-02f, 1.154782064e-02f, 9.999999776e-03f, 8.659643121e-03f, 7.498941850e-03f, 6.493816152e-03f, 5.623413250e-03f, 4.869675264e-03f, 4.216964822e-03f, 3.651741194e-03f, 3.162277630e-03f, 2.738419687e-03f, 2.371373586e-03f, 2.053524833e-03f, 1.778279431e-03f, 1.539926510e-03f, 1.333521446e-03f, 1.154781901e-03f, 1.000000047e-03f, 8.659643354e-04f, 7.498942432e-04f, 6.493816618e-04f, 5.623413017e-04f, 4.869675322e-04f, 4.216965172e-04f, 3.651741426e-04f, 3.162277571e-04f, 2.738419571e-04f, 2.371373703e-04f, 2.053525095e-04f, 1.778279402e-04f, 1.539926452e-04f, 1.333521504e-04f, 1.154782003e-04f};

__device__ __forceinline__ unsigned cvt_pk_bf16(float lo, float hi) { unsigned r; asm volatile("v_cvt_pk_bf16_f32 %0, %1, %2" : "=v"(r) : "v"(lo), "v"(hi)); return r; }
__device__ __forceinline__ float bf_lo(unsigned w) { return __uint_as_float(w << 16); }
__device__ __forceinline__ float bf_hi(unsigned w) { return __uint_as_float(w & 0xffff0000u); }
__device__ __forceinline__ float fast_sigmoid(float a) { return __builtin_amdgcn_rcpf(1.0f + __builtin_amdgcn_exp2f(a * (-1.4426950408889634f))); }
__device__ __forceinline__ float xor32_sum(float v) { auto rr = __builtin_amdgcn_permlane32_swap(__float_as_uint(v), __float_as_uint(v), false, false); return __uint_as_float(rr[0]) + __uint_as_float(rr[1]); }
__device__ __forceinline__ float xor32_max(float v) { auto rr = __builtin_amdgcn_permlane32_swap(__float_as_uint(v), __float_as_uint(v), false, false); return fmaxf(__uint_as_float(rr[0]), __uint_as_float(rr[1])); }
__device__ __forceinline__ float xor32_get(float v, int hi) { auto rr = __builtin_amdgcn_permlane32_swap(__float_as_uint(v), __float_as_uint(v), false, false); return __uint_as_float(hi ? rr[0] : rr[1]); }
__device__ __forceinline__ int sbfe1(unsigned v, int bit) { int r; asm("v_bfe_i32 %0, %1, %2, 1" : "=v"(r) : "v"(v), "n"(bit)); return r; }
__device__ __forceinline__ float max3f(float a, float b, float c) { float r; asm("v_max3_f32 %0, %1, %2, %3" : "=v"(r) : "v"(a), "v"(b), "v"(c)); return r; }
__device__ __forceinline__ int crow(int r, int hi) { return (r & 3) + 8 * (r >> 2) + 4 * hi; }
__device__ __forceinline__ float wave_sum(float v, int lane) {
#pragma unroll
    for (int o = 1; o < 64; o <<= 1) v += __int_as_float(__builtin_amdgcn_ds_bpermute((lane ^ o) << 2, __float_as_int(v)));
    return v;
}


#define XB_TMO      128
#define XB_XCNT(j)  (256  + 64 * (j))
#define XB_XSUB(j)  (1280 + 64 * (j))
#define XB_XGEN(j)  (2304 + 64 * (j))
#define XB_TOP      3328
#define XB_TOPGEN   3392
#define XCD_BAR_WORDS 3456
#define XB_SPIN_CAP (1u << 22)
__device__ __forceinline__ unsigned xb_ld(unsigned* p)              { return __hip_atomic_load(p, __ATOMIC_RELAXED, __HIP_MEMORY_SCOPE_AGENT); }
__device__ __forceinline__ unsigned xb_add(unsigned* p, unsigned v) { return __hip_atomic_fetch_add(p, v, __ATOMIC_RELAXED, __HIP_MEMORY_SCOPE_AGENT); }
__device__ __forceinline__ unsigned xb_xcc_id() { return (unsigned)__builtin_amdgcn_s_getreg((3 << 11) | 20) & 0xFu; }
#define XB_SPIN(cond, bar) do { unsigned _sp = 0; while (cond) { __builtin_amdgcn_s_sleep(1); \
    if ((++_sp & 255u) == 0u) { if (xb_ld(&(bar)[XB_TMO])) break; if (_sp > XB_SPIN_CAP) { atomicAdd(&(bar)[XB_TMO], 1u); break; } } } } while (0)
__device__ __forceinline__ void xcd_barrier_complete(unsigned* bar, unsigned x, unsigned G, unsigned& nloc, unsigned& nx) {
    unsigned sum, cnt, mine, sp = 0u;
    for (;;) {
        sum = 0u; cnt = 0u; mine = 0u;
#pragma unroll
        for (unsigned j = 0; j < 16; ++j) { const unsigned c = xb_ld(&bar[XB_XCNT(j)]); sum += c; cnt += (c > 0u) ? 1u : 0u; mine = (j == x) ? c : mine; }
        if (sum == G) break;
        __builtin_amdgcn_s_sleep(1);
        if ((++sp & 255u) == 0u) { if (xb_ld(&bar[XB_TMO])) break; if (sp > XB_SPIN_CAP) { atomicAdd(&bar[XB_TMO], 1u); break; } }
    }
    nloc = mine > 0u ? mine : 1u; nx = cnt > 0u ? cnt : 1u;
}
__device__ __forceinline__ void xcd_barrier(unsigned* bar, volatile LAS unsigned* st, int tid, unsigned G) {
    asm volatile("s_waitcnt vmcnt(0)" ::: "memory");
    __syncthreads();
    if (tid == 0) {
        const unsigned x = xb_xcc_id();
        __builtin_amdgcn_s_waitcnt(0);
        unsigned nloc = st[0], nx = st[1];
        if (nloc == 0u) { xcd_barrier_complete(bar, x, G, nloc, nx); st[0] = nloc; st[1] = nx; }
        const unsigned old = xb_add(&bar[XB_XSUB(x)], 1u);
        const unsigned gen = old / nloc;
        if (old + 1u == (gen + 1u) * nloc) {
            __builtin_amdgcn_fence(__ATOMIC_RELEASE, "agent");
            asm volatile("s_waitcnt vmcnt(0)" ::: "memory");
            const unsigned og = xb_add(&bar[XB_TOP], 1u);
            const unsigned tg = og / nx;
            if (og + 1u == (tg + 1u) * nx) xb_add(&bar[XB_TOPGEN], 1u);
            else XB_SPIN(xb_ld(&bar[XB_TOPGEN]) == tg, bar);
            __builtin_amdgcn_fence(__ATOMIC_ACQUIRE, "agent");
            xb_add(&bar[XB_XGEN(x)], 1u);
            asm volatile("s_waitcnt vmcnt(0)" ::: "memory");
        } else {
            XB_SPIN(xb_ld(&bar[XB_XGEN(x)]) == gen, bar);
            __builtin_amdgcn_fence(__ATOMIC_ACQUIRE, "agent");
            asm volatile("s_waitcnt vmcnt(0)" ::: "memory");
        }
    }
    __syncthreads();
}

namespace pg8 {
constexpr int BM = 256, BK = 64, HALF = 128, HTB = HALF * BK * 2, STAGE_BYTES = 8 * HTB, NXCD = 8, WGM = 8;
__host__ __device__ __forceinline__ int lds_byte(int r, int c) { const int st = (r >> 4) * 2 + (c >> 5), rr = r & 15, cc = c & 31, ob = rr * 64 + cc * 2; return st * 1024 + (ob ^ (((ob >> 9) & 1) << 5)); }
__host__ __device__ __forceinline__ void stage_rc(int b, int& R, int& C) { const int st = b / 1024, sb = b % 1024, swz = sb ^ (((sb >> 9) & 1) << 5); R = (st >> 1) * 16 + swz / 64; C = (st & 1) * 32 + (swz % 64) / 2; }
__host__ __device__ __forceinline__ int perm32(int rho) { const int n = rho >> 4, i = rho & 15; return 8 * (i >> 2) + 4 * n + (i & 3); }
struct Unit { int pm, pn; };
struct Gemm { const bf16_t* A; const bf16_t* Bt; int M, N, K; };
struct StaticOrder {
    int nM, nN, nwg, G, c;
    __host__ __device__ void init(int M, int N, int G_, int c_) { nM = M / BM; nN = N / BM; nwg = nM * nN; G = G_; c = c_; }
    __host__ __device__ bool next(int i, Unit& u) const {
        const long L = (long)i * G + c; if (L >= nwg) return false;
        int wgid = (int)L; { const int q = nwg / NXCD, r = nwg % NXCD, xcd = wgid % NXCD, off = wgid / NXCD; wgid = (xcd < r ? xcd * (q + 1) : r * (q + 1) + (xcd - r) * q) + off; }
        const int nig = WGM * nN, gid = wgid / nig, fm = gid * WGM, gsz = (nM - fm) < WGM ? (nM - fm) : WGM;
        u.pm = fm + ((wgid % nig) % gsz); u.pn = (wgid % nig) / gsz; return true;
    }
};

enum { MODE_INA = 0, MODE_QG = 1, MODE_PLAIN = 2, MODE_OUT = 3, MODE_GATE = 4 };
struct Epi {
    int mode; unsigned char* ws; const float* xin; float* xf; bf16_t* O; int ldc; float ymul; int layer;
    __device__ __forceinline__ void operator()(const f32x4 (&acc)[2][2][4][2], const Unit& u, int wr, int wc, int fr, int fq) const {
        asm volatile("" : "+v"(fr), "+v"(fq));
        const int pn = u.pn;
        const int row0 = u.pm * BM + wr * 64 + fr;
        const int colw = wc * 32 + 8 * fq;
        if (mode == MODE_PLAIN) {
#pragma unroll
            for (int ai = 0; ai < 2; ++ai)
#pragma unroll
                for (int m = 0; m < 4; ++m) { bf16_t* rowp = O + (size_t)(row0 + ai * HALF + m * 16) * ldc + pn * BM + colw;
#pragma unroll
                    for (int bj = 0; bj < 2; ++bj) { const f32x4 v0 = acc[ai][bj][m][0], v1 = acc[ai][bj][m][1];
                        u32x4 w; w.x = cvt_pk_bf16(v0[0], v0[1]); w.y = cvt_pk_bf16(v0[2], v0[3]); w.z = cvt_pk_bf16(v1[0], v1[1]); w.w = cvt_pk_bf16(v1[2], v1[3]);
                        *(GAS u32x4*)(rowp + bj * HALF) = w; } }
        } else if (mode == MODE_OUT) {
            const GAS float* lnp = (const GAS float*)(ws + WS_LNP) + (size_t)layer * 4 * DM;
            GAS float* stats = (GAS float*)(ws + WS_STATS) + (size_t)layer * T * 2;
            bf16_t* zb = (bf16_t*)(ws + WS_QO); const bf16_t* xb2r = (const bf16_t*)(ws + WS_XB2);
            const int col0 = pn * BM + colw, lane = fr + 16 * fq;
            f32x4 gv[2][2];
#pragma unroll
            for (int bj = 0; bj < 2; ++bj)
#pragma unroll
                for (int n = 0; n < 2; ++n) gv[bj][n] = *(const GAS f32x4*)(lnp + col0 + bj * HALF + 4 * n);
#pragma unroll
            for (int ai = 0; ai < 2; ++ai) {
                u32x4 xwv[4][2];
#pragma unroll
                for (int i = 0; i < 4; ++i)
#pragma unroll
                    for (int bj = 0; bj < 2; ++bj) xwv[i][bj] = *(const GAS u32x4*)(xb2r + (size_t)(row0 + ai * HALF + i * 16) * DM + col0 + bj * HALF);
#pragma unroll
                for (int m = 0; m < 4; ++m) { const int row = row0 + ai * HALF + m * 16; const size_t off = (size_t)row * DM + col0;
                    float s1 = 0.f, s2 = 0.f;
#pragma unroll
                    for (int bj = 0; bj < 2; ++bj) { f32x4 z[2];
                        const u32x4 xw = xwv[m][bj];
#pragma unroll
                        for (int n = 0; n < 2; ++n) { const f32x4 xv = n == 0 ? (f32x4){bf_lo(xw.x), bf_hi(xw.x), bf_lo(xw.y), bf_hi(xw.y)} : (f32x4){bf_lo(xw.z), bf_hi(xw.z), bf_lo(xw.w), bf_hi(xw.w)};
                            z[n] = xv * DN_ALPHA + acc[ai][bj][m][n] * ymul;
                            s1 += (z[n][0] + z[n][1]) + (z[n][2] + z[n][3]); s2 += (z[n][0] * z[n][0] + z[n][1] * z[n][1]) + (z[n][2] * z[n][2] + z[n][3] * z[n][3]); }
                        const f32x4 y0 = z[0] * gv[bj][0], y1 = z[1] * gv[bj][1];
                        u32x4 w; w.x = cvt_pk_bf16(y0[0], y0[1]); w.y = cvt_pk_bf16(y0[2], y0[3]); w.z = cvt_pk_bf16(y1[0], y1[1]); w.w = cvt_pk_bf16(y1[2], y1[3]);
                        *(GAS u32x4*)(zb + off + bj * HALF) = w; }
                    s1 += __int_as_float(__builtin_amdgcn_ds_bpermute((lane ^ 16) << 2, __float_as_int(s1)));
                    s2 += __int_as_float(__builtin_amdgcn_ds_bpermute((lane ^ 16) << 2, __float_as_int(s2)));
                    s1 = xor32_sum(s1); s2 = xor32_sum(s2);
                    if (fq == 0) { __hip_atomic_fetch_add(stats + (size_t)row * 2, s1, __ATOMIC_RELAXED, __HIP_MEMORY_SCOPE_AGENT);
                                   __hip_atomic_fetch_add(stats + (size_t)row * 2 + 1, s2, __ATOMIC_RELAXED, __HIP_MEMORY_SCOPE_AGENT); } }
            }
        } else if (mode == MODE_GATE) {
            const GAS float* lnp = (const GAS float*)(ws + WS_LNP) + (size_t)layer * 4 * DM;
            const GAS float* stats = (const GAS float*)(ws + WS_STATS) + (size_t)layer * T * 2;
            const bf16_t* ple = (const bf16_t*)(ws + WS_SGP); bf16_t* xb2 = (bf16_t*)(ws + WS_XB2); const bf16_t* zb = (const bf16_t*)(ws + WS_QO);
#pragma unroll
            for (int bj = 0; bj < 2; ++bj) {
                const int c = pn * BM + bj * HALF + colw;
                const f32x4 g0 = *(const GAS f32x4*)(lnp + c), g1 = *(const GAS f32x4*)(lnp + c + 4), b0 = *(const GAS f32x4*)(lnp + DM + c), b1 = *(const GAS f32x4*)(lnp + DM + c + 4);
                const f32x4 gG0 = *(const GAS f32x4*)(lnp + 2 * DM + c), gG1 = *(const GAS f32x4*)(lnp + 2 * DM + c + 4);
                const f32x4 nbG0 = *(const GAS f32x4*)(lnp + 3 * DM + c) * (-LOG2E), nbG1 = *(const GAS f32x4*)(lnp + 3 * DM + c + 4) * (-LOG2E);
#pragma unroll
                for (int ai = 0; ai < 2; ++ai) {
#pragma unroll
                    for (int m = 0; m < 4; ++m) { const int row = row0 + ai * HALF + m * 16; const size_t off = (size_t)row * DM + c;
                        const u32x4 zw = *(const GAS u32x4*)(zb + off);
                        const u32x4 pw = *(const GAS u32x4*)(ple + off);
                        const f32x2 st = *(const GAS f32x2*)(stats + (size_t)row * 2);
                        asm volatile("" :: "v"(zw), "v"(pw), "v"(st));
                        const float mean = st.x * (1.0f / DM), var = st.y * (1.0f / DM) - mean * mean, rstd = __builtin_amdgcn_rsqf(var + LN_EPS);
                        const float Bc = -mean * rstd, An = -rstd * LOG2E, Bn = mean * rstd * LOG2E;
                        const f32x4 zg0 = (f32x4){bf_lo(zw.x), bf_hi(zw.x), bf_lo(zw.y), bf_hi(zw.y)}, zg1 = (f32x4){bf_lo(zw.z), bf_hi(zw.z), bf_lo(zw.w), bf_hi(zw.w)};
                        const f32x4 x0 = zg0 * rstd + (g0 * Bc + b0), x1 = zg1 * rstd + (g1 * Bc + b1);
                        const f32x4 t0 = acc[ai][bj][m][0] * An + (gG0 * Bn + nbG0), t1 = acc[ai][bj][m][1] * An + (gG1 * Bn + nbG1);
                        f32x4 o0, o1;
#define SIGX(t) __builtin_amdgcn_rcpf(1.0f + __builtin_amdgcn_exp2f(t))
                        o0[0] = x0[0] + bf_lo(pw.x) * SIGX(t0[0]); o0[1] = x0[1] + bf_hi(pw.x) * SIGX(t0[1]);
                        o0[2] = x0[2] + bf_lo(pw.y) * SIGX(t0[2]); o0[3] = x0[3] + bf_hi(pw.y) * SIGX(t0[3]);
                        o1[0] = x1[0] + bf_lo(pw.z) * SIGX(t1[0]); o1[1] = x1[1] + bf_hi(pw.z) * SIGX(t1[1]);
                        o1[2] = x1[2] + bf_lo(pw.w) * SIGX(t1[2]); o1[3] = x1[3] + bf_hi(pw.w) * SIGX(t1[3]);
#undef SIGX
                        if (layer == 3) { *(GAS f32x4*)(xf + off) = o0; *(GAS f32x4*)(xf + off + 4) = o1; }
                        u32x4 w; w.x = cvt_pk_bf16(o0[0], o0[1]); w.y = cvt_pk_bf16(o0[2], o0[3]); w.z = cvt_pk_bf16(o1[0], o1[1]); w.w = cvt_pk_bf16(o1[2], o1[3]);
                        *(GAS u32x4*)(xb2 + off) = w; }
                }
            }
        } else if (mode == MODE_QG) {
            const bool isq = pn < 8;
            bf16_t* base = isq ? (bf16_t*)(ws + WS_QO) + pn * BM : (bf16_t*)(ws + WS_SGP) + (pn - 8) * BM;
#pragma unroll
            for (int ai = 0; ai < 2; ++ai)
#pragma unroll
                for (int m = 0; m < 4; ++m) { bf16_t* rowp = base + (size_t)(row0 + ai * HALF + m * 16) * DM + colw;
#pragma unroll
                    for (int bj = 0; bj < 2; ++bj) { f32x4 v0 = acc[ai][bj][m][0], v1 = acc[ai][bj][m][1];
                        if (isq) { v0 = v0 * (QSCALE * LOG2E); v1 = v1 * (QSCALE * LOG2E); }
                        else {
#pragma unroll
                            for (int j = 0; j < 4; ++j) { v0[j] = v0[j] * fast_sigmoid(v0[j]); v1[j] = v1[j] * fast_sigmoid(v1[j]); } }
                        u32x4 w; w.x = cvt_pk_bf16(v0[0], v0[1]); w.y = cvt_pk_bf16(v0[2], v0[3]); w.z = cvt_pk_bf16(v1[0], v1[1]); w.w = cvt_pk_bf16(v1[2], v1[3]);
                        *(GAS u32x4*)(rowp + bj * HALF) = w; } }
        } else {
            const GAS f32x4* cs128 = (const GAS f32x4*)(ws + WS_CS128); const GAS f32x4* cs64 = (const GAS f32x4*)(ws + WS_CS64);
            const bool rope = pn < 10 || pn >= 18;
            const GAS f32x4* tb = pn < 10 ? cs128 + wc * 8 + fq * 2 : cs64 + (wc & 1) * 8 + fq * 2;
            const int tstride = pn < 10 ? 32 : 16;
#pragma unroll
            for (int ai = 0; ai < 2; ++ai) {
                f32x4 cv[4][2];
                if (rope) {
#pragma unroll
                    for (int m = 0; m < 4; ++m) { const GAS f32x4* tp = tb + (size_t)(row0 + ai * HALF + m * 16) * tstride; cv[m][0] = tp[0]; cv[m][1] = tp[1]; }
                }
#pragma unroll
                for (int m = 0; m < 4; ++m) {
                    const int row = row0 + ai * HALF + m * 16;
                    if (pn < 10) {
                        const f32x4 c0 = cv[m][0], c1 = cv[m][1];
                        const float sc = pn < 8 ? QSCALE * LOG2E : 1.0f;
                        bf16_t* rowp = (pn < 8 ? (bf16_t*)(ws + WS_QO) + (size_t)row * DM + pn * BM : (bf16_t*)(ws + WS_KA) + (size_t)row * 512 + (pn - 8) * BM) + colw;
#pragma unroll
                        for (int bj = 0; bj < 2; ++bj) { const f32x4 v0 = acc[ai][bj][m][0] * sc, v1 = acc[ai][bj][m][1] * sc;
                            u32x4 w;
                            w.x = cvt_pk_bf16(v0[0] * c0[0] - v0[1] * c0[1], v0[1] * c0[0] + v0[0] * c0[1]);
                            w.y = cvt_pk_bf16(v0[2] * c0[2] - v0[3] * c0[3], v0[3] * c0[2] + v0[2] * c0[3]);
                            w.z = cvt_pk_bf16(v1[0] * c1[0] - v1[1] * c1[1], v1[1] * c1[0] + v1[0] * c1[1]);
                            w.w = cvt_pk_bf16(v1[2] * c1[2] - v1[3] * c1[3], v1[3] * c1[2] + v1[2] * c1[3]);
                            *(GAS u32x4*)(rowp + bj * HALF) = w; }
                    } else if (pn < 18) {
                        bf16_t* rowp = (bf16_t*)(ws + WS_SGP) + (size_t)row * DM + (pn - 10) * BM + colw;
#pragma unroll
                        for (int bj = 0; bj < 2; ++bj) { f32x4 v0 = acc[ai][bj][m][0], v1 = acc[ai][bj][m][1];
#pragma unroll
                            for (int j = 0; j < 4; ++j) { v0[j] = v0[j] * fast_sigmoid(v0[j]); v1[j] = v1[j] * fast_sigmoid(v1[j]); }
                            u32x4 w; w.x = cvt_pk_bf16(v0[0], v0[1]); w.y = cvt_pk_bf16(v0[2], v0[3]); w.z = cvt_pk_bf16(v1[0], v1[1]); w.w = cvt_pk_bf16(v1[2], v1[3]);
                            *(GAS u32x4*)(rowp + bj * HALF) = w; }
                    } else {
                        const f32x4 c0 = cv[m][0], c1 = cv[m][1];
#pragma unroll
                        for (int bj = 0; bj < 2; ++bj) { const f32x4 v0 = acc[ai][bj][m][0], v1 = acc[ai][bj][m][1];
                            u32x4 w;
                            w.x = cvt_pk_bf16(v0[0] * c0[0] - v0[1] * c0[1], v0[1] * c0[0] + v0[0] * c0[1]);
                            w.y = cvt_pk_bf16(v0[2] * c0[2] - v0[3] * c0[3], v0[3] * c0[2] + v0[2] * c0[3]);
                            w.z = cvt_pk_bf16(v1[0] * c1[0] - v1[1] * c1[1], v1[1] * c1[0] + v1[0] * c1[1]);
                            w.w = cvt_pk_bf16(v1[2] * c1[2] - v1[3] * c1[3], v1[3] * c1[2] + v1[2] * c1[3]);
                            if (pn < 22) { *(GAS u32x4*)((bf16_t*)(ws + WS_QI) + (size_t)row * 1024 + (pn - 18) * BM + bj * HALF + colw) = w; }
                            else if (bj == 0) {
                                if (wc < 2) *(GAS u32x4*)((bf16_t*)(ws + WS_KI) + (size_t)row * 64 + colw) = w;
                                else if (wc == 2 && fq < 2) { float* wp = (float*)(ws + WS_WI) + (size_t)row * 16 + 8 * fq;
                                    *(GAS f32x4*)(wp) = v0 * 0.03125f; *(GAS f32x4*)(wp + 4) = v1 * 0.03125f; }
                            } }
                    }
                }
            }
        }
    }
};

template <class EpiT, class Sched>
__device__ __forceinline__ void gemm_phase(LAS unsigned char* lds, const Gemm g, const Sched& S, const EpiT& E, const int wid) {
    constexpr bool ALIGN_EPI = true;
    int lane; asm volatile("v_mbcnt_lo_u32_b32 %0, -1, 0\n\tv_mbcnt_hi_u32_b32 %0, -1, %0" : "=v"(lane));
    const int tid = wid * 64 + lane, wr = wid >> 2, wc = wid & 3, fr = lane & 15, fq = lane >> 4;
    const int K = g.K, nt = K / BK;
    unsigned voffA[2], voffB[2];
#pragma unroll
    for (int i = 0; i < 2; ++i) { int R, C; stage_rc(tid * 16 + i * 8192, R, C); const int Rb = (R & ~31) + perm32(R & 31);
        voffA[i] = (unsigned)(R * K + C) * 2u; voffB[i] = (unsigned)(Rb * K + C) * 2u; }
    const size_t kstep = (size_t)(BK * 2);
    const size_t hstep = (size_t)HALF * K * 2;
    const size_t tstep = 2 * hstep;
    const unsigned ldsw = (unsigned)wid * 1024u;
    const int aoff = lds_byte(wr * 64 + fr, fq * 8), boff = lds_byte(wc * 32 + fr, fq * 8);
#define PG8_SA(b, h) (((b) * 2 + (h)) * HTB)
#define PG8_SB(b, h) ((4 + (b) * 2 + (h)) * HTB)
#define PG8_STAGE(bufoff, gbase, voff) do { _Pragma("unroll") for (int _i = 0; _i < 2; ++_i) \
        __builtin_amdgcn_global_load_lds((const unsigned*)((const char*)(gbase) + (voff)[_i]), (LAS unsigned*)(lds + (bufoff) + ldsw + _i * 8192), 16, 0, 0); } while (0)
#define PG8_LDA(dst, b, h) do { _Pragma("unroll") for (int m = 0; m < 4; ++m) _Pragma("unroll") for (int k = 0; k < 2; ++k) dst[m][k] = *(const LAS bf16x8*)(lds + PG8_SA(b, h) + aoff + m * 2048 + k * 1024); } while (0)
#define PG8_LDB(dst, b, h) do { _Pragma("unroll") for (int n = 0; n < 2; ++n) _Pragma("unroll") for (int k = 0; k < 2; ++k) dst[n][k] = *(const LAS bf16x8*)(lds + PG8_SB(b, h) + boff + n * 2048 + k * 1024); } while (0)
#define PG8_MMA(ai, bj, At, Bt) do { __builtin_amdgcn_s_setprio(1); _Pragma("unroll") for (int m = 0; m < 4; ++m) _Pragma("unroll") for (int n = 0; n < 2; ++n) _Pragma("unroll") for (int k = 0; k < 2; ++k) \
        acc[ai][bj][m][n] = __builtin_amdgcn_mfma_f32_16x16x32_bf16(Bt[n][k], At[m][k], acc[ai][bj][m][n], 0, 0, 0); __builtin_amdgcn_s_setprio(0); } while (0)
#define PG8_WAIT_V(n) asm volatile("s_waitcnt vmcnt(" #n ")" ::: "memory")
#define PG8_WAIT_L(n) asm volatile("s_waitcnt lgkmcnt(" #n ")" ::: "memory")
#define PG8_BAR __builtin_amdgcn_s_barrier()
#define PG8_SCHED __builtin_amdgcn_sched_barrier(0)
    Unit cur, nxt; int ui = 0;
    if (!S.next(0, cur)) return;
    f32x4 acc[2][2][4][2];
#pragma unroll
    for (int a = 0; a < 2; ++a)
#pragma unroll
        for (int b = 0; b < 2; ++b)
#pragma unroll
            for (int m = 0; m < 4; ++m)
#pragma unroll
                for (int n = 0; n < 2; ++n) acc[a][b][m][n] = (f32x4){0.f, 0.f, 0.f, 0.f};
    bf16x8 At[4][2], B0[2][2], B1[2][2];
    const char* cA = (const char*)g.A + (size_t)cur.pm * tstep; const char* cB = (const char*)g.Bt + (size_t)cur.pn * tstep;
    PG8_STAGE(PG8_SB(0, 0), cB, voffB); PG8_STAGE(PG8_SB(0, 1), cB + hstep, voffB); PG8_STAGE(PG8_SA(0, 0), cA, voffA); PG8_STAGE(PG8_SA(0, 1), cA + hstep, voffA);
    if (wr == 1) PG8_BAR;
    PG8_WAIT_V(2); PG8_BAR;
    PG8_STAGE(PG8_SB(1, 0), cB + kstep, voffB); PG8_STAGE(PG8_SA(1, 0), cA + kstep, voffA); PG8_STAGE(PG8_SB(1, 1), cB + hstep + kstep, voffB);
    PG8_WAIT_V(6); PG8_BAR;
    for (;;) {
        const bool has_next = S.next(ui + 1, nxt);
        const char* nA = has_next ? (const char*)g.A + (size_t)nxt.pm * tstep : cA; const char* nB = has_next ? (const char*)g.Bt + (size_t)nxt.pn * tstep : cB;
        for (int t = 0; t < nt; t += 2) {
            const bool last = (t == nt - 2);
            const char* a1 = cA + (size_t)(t + 1) * kstep;
            const char* a2 = last ? nA : cA + (size_t)(t + 2) * kstep; const char* b2 = last ? nB : cB + (size_t)(t + 2) * kstep;
            const char* a3 = a2 + kstep; const char* b3 = b2 + kstep;
            PG8_LDB(B0, 0, 0); PG8_LDB(B1, 0, 1); PG8_SCHED; PG8_LDA(At, 0, 0); PG8_STAGE(PG8_SA(1, 1), a1 + hstep, voffA);
            PG8_WAIT_V(8); PG8_WAIT_L(0); PG8_BAR; PG8_MMA(0, 0, At, B0); PG8_MMA(0, 1, At, B1); PG8_BAR; PG8_SCHED;
            PG8_LDA(At, 0, 1); PG8_STAGE(PG8_SB(0, 0), b2, voffB); PG8_STAGE(PG8_SB(0, 1), b2 + hstep, voffB); PG8_STAGE(PG8_SA(0, 0), a2, voffA);
            PG8_WAIT_V(8); PG8_WAIT_L(0); PG8_BAR; PG8_MMA(1, 0, At, B0); PG8_MMA(1, 1, At, B1); PG8_BAR; PG8_SCHED;
            PG8_LDB(B0, 1, 0); PG8_LDB(B1, 1, 1); PG8_SCHED; PG8_LDA(At, 1, 0); PG8_STAGE(PG8_SA(0, 1), a2 + hstep, voffA);
            PG8_WAIT_V(8); PG8_WAIT_L(0); PG8_BAR; PG8_MMA(0, 0, At, B0); PG8_MMA(0, 1, At, B1); PG8_BAR; PG8_SCHED;
            PG8_LDA(At, 1, 1); PG8_STAGE(PG8_SB(1, 0), b3, voffB); PG8_STAGE(PG8_SB(1, 1), b3 + hstep, voffB); PG8_STAGE(PG8_SA(1, 0), a3, voffA);
            PG8_WAIT_V(8); PG8_WAIT_L(0); PG8_BAR; PG8_MMA(1, 0, At, B0); PG8_MMA(1, 1, At, B1); PG8_BAR; PG8_SCHED;
        }
        if constexpr (ALIGN_EPI) { if (wr == 0) PG8_BAR; }
        E(acc, cur, wr, wc, fr, fq);
        if (!has_next) break;
#pragma unroll
        for (int a = 0; a < 2; ++a)
#pragma unroll
            for (int b = 0; b < 2; ++b)
#pragma unroll
                for (int m = 0; m < 4; ++m)
#pragma unroll
                    for (int n = 0; n < 2; ++n) acc[a][b][m][n] = (f32x4){0.f, 0.f, 0.f, 0.f};
        cur = nxt; cA = nA; cB = nB; ++ui;
        if constexpr (ALIGN_EPI) { if (wr == 1) PG8_BAR; }
    }
    PG8_WAIT_V(0);
    if constexpr (!ALIGN_EPI) { if (wr == 0) PG8_BAR; }
    PG8_BAR;
#undef PG8_SA
#undef PG8_SB
#undef PG8_STAGE
#undef PG8_LDA
#undef PG8_LDB
#undef PG8_MMA
#undef PG8_WAIT_V
#undef PG8_WAIT_L
#undef PG8_BAR
#undef PG8_SCHED
}
}

struct Args {
    const float* x; const float* p; const int* pos; const float* w_in_a; const float* w_out_a; const float* w_q_b; const float* w_kv_b; const float* w_out_b;
    const float* ln_g; const float* ln_b; const float* w_ple; const float* w_ple_gate; float* out; unsigned char* ws; int ph_lo, ph_hi;
};

__device__ __forceinline__ int mapA(int n) {
    if (n < 2560) { const int head = n >> 7, w = n & 127; return head * 128 + (w >> 1) + 64 * (w & 1); }
    if (n < 4608) return 3072 + (n - 2560);
    if (n < 5632) { const int c = n - 4608, head = c >> 6, w = c & 63; return 5120 + head * 64 + (w >> 1) + 32 * (w & 1); }
    if (n < 5696) { const int w = n - 5632; return 6160 + (w >> 1) + 32 * (w & 1); }
    if (n < 5712) return 6144 + (n - 5696);
    if (n < 5888) return -1;
    return 2560 + (n - 5888);
}
template <bool MAPA>
__device__ __forceinline__ void transpose_item(const float* W, int K, int N, int NP, bf16_t* WT, LAS float* scr, int item, int lane) {
    const int nblk = NP / 32, kb = item / nblk, nb = item % nblk, k0 = 64 * kb, n0 = 32 * nb;
    const int nphys = n0 + (lane & 31);
    const int src = MAPA ? mapA(nphys) : nphys;
#pragma unroll
    for (int i = 0; i < 32; ++i) { const int kk = 2 * i + (lane >> 5); scr[kk * 33 + (lane & 31)] = src >= 0 ? ((const GAS float*)W)[(size_t)(k0 + kk) * N + src] : 0.f; }
    asm volatile("s_waitcnt lgkmcnt(0)" ::: "memory");
    const int c = lane & 7;
#pragma unroll
    for (int j = 0; j < 4; ++j) { const int n = (lane >> 3) + 8 * j; const LAS float* s = scr + (8 * c) * 33 + n;
        u32x4 o; o.x = cvt_pk_bf16(s[0 * 33], s[1 * 33]); o.y = cvt_pk_bf16(s[2 * 33], s[3 * 33]); o.z = cvt_pk_bf16(s[4 * 33], s[5 * 33]); o.w = cvt_pk_bf16(s[6 * 33], s[7 * 33]);
        *(GAS u32x4*)(WT + (size_t)(n0 + n) * K + k0 + 8 * c) = o; }
    asm volatile("s_waitcnt lgkmcnt(0)" ::: "memory");
}
__device__ __forceinline__ void cvt_rows(const float* src, bf16_t* dst, size_t n8, size_t gtid, size_t gthreads) {
    size_t i = gtid;
    for (; i + 3 * gthreads < n8; i += 4 * gthreads) {
        f32x4 a[4], b[4];
#pragma unroll
        for (int j = 0; j < 4; ++j) { a[j] = *(const GAS f32x4*)(src + (i + j * gthreads) * 8); b[j] = *(const GAS f32x4*)(src + (i + j * gthreads) * 8 + 4); }
#pragma unroll
        for (int j = 0; j < 4; ++j) { u32x4 w; w.x = cvt_pk_bf16(a[j][0], a[j][1]); w.y = cvt_pk_bf16(a[j][2], a[j][3]); w.z = cvt_pk_bf16(b[j][0], b[j][1]); w.w = cvt_pk_bf16(b[j][2], b[j][3]);
            *(GAS u32x4*)(dst + (i + j * gthreads) * 8) = w; }
    }
    for (; i < n8; i += gthreads) { const f32x4 a = *(const GAS f32x4*)(src + i * 8), b = *(const GAS f32x4*)(src + i * 8 + 4);
        u32x4 w; w.x = cvt_pk_bf16(a[0], a[1]); w.y = cvt_pk_bf16(a[2], a[3]); w.z = cvt_pk_bf16(b[0], b[1]); w.w = cvt_pk_bf16(b[2], b[3]);
        *(GAS u32x4*)(dst + i * 8) = w; }
}
__device__ __forceinline__ void prologue(const Args& a, LAS unsigned char* lds, int bx, int G, int tid, int wave, int lane) {
    LAS float* scr = (LAS float*)(lds + wave * 16384);
    const int gw = bx * NWAVES + wave, NGW = G * NWAVES;
    unsigned char* ws = a.ws;
    constexpr int I_INA = (DM / 64) * (AWP / 32);
    constexpr int I_SQ = (DM / 64) * (DM / 32);
    constexpr int I_W4 = (DM / 64) * (4096 / 32);
    constexpr int I_PLE = (PLE / 64) * (DM / 32);
    constexpr int NITEMS = 2 * I_INA + 2 * I_SQ + 2 * I_W4 + I_W4 + 2 * I_SQ + 4 * I_PLE + 4 * I_SQ;
    for (int it = gw; it < NITEMS; it += NGW) {
        int r = it;
        if (r < 2 * I_INA) { const int l = r / I_INA; transpose_item<true>(a.w_in_a + (size_t)l * DM * AW, DM, AW, AWP, (bf16_t*)(ws + WS_WINA) + (size_t)l * AWP * DM, scr, r % I_INA, lane); continue; } r -= 2 * I_INA;
        if (r < 2 * I_SQ) { const int l = r / I_SQ; transpose_item<false>(a.w_out_a + (size_t)l * DM * DM, DM, DM, DM, (bf16_t*)(ws + WS_WOUTA) + (size_t)l * DM * DM, scr, r % I_SQ, lane); continue; } r -= 2 * I_SQ;
        if (r < 2 * I_W4) { const int l = r / I_W4; transpose_item<false>(a.w_q_b + (size_t)l * DM * 4096, DM, 4096, 4096, (bf16_t*)(ws + WS_WQB) + (size_t)l * 4096 * DM, scr, r % I_W4, lane); continue; } r -= 2 * I_W4;
        if (r < I_W4) { transpose_item<false>(a.w_kv_b, DM, 4096, 4096, (bf16_t*)(ws + WS_WKV), scr, r, lane); continue; } r -= I_W4;
        if (r < 2 * I_SQ) { const int l = r / I_SQ; transpose_item<false>(a.w_out_b + (size_t)l * DM * DM, DM, DM, DM, (bf16_t*)(ws + WS_WOUTB) + (size_t)l * DM * DM, scr, r % I_SQ, lane); continue; } r -= 2 * I_SQ;
        if (r < 4 * I_PLE) { const int l = r / I_PLE; transpose_item<false>(a.w_ple + (size_t)l * PLE * DM, PLE, DM, DM, (bf16_t*)(ws + WS_WPLE) + (size_t)l * DM * PLE, scr, r % I_PLE, lane); continue; } r -= 4 * I_PLE;
        { const int l = r / I_SQ; transpose_item<false>(a.w_ple_gate + (size_t)l * DM * DM, DM, DM, DM, (bf16_t*)(ws + WS_WG) + (size_t)l * DM * DM, scr, r % I_SQ, lane); }
    }
    if (bx == 0) { unsigned* bar = (unsigned*)(ws + WS_BAR); for (int i = tid; i < XCD_BAR_WORDS; i += NTHREADS) __hip_atomic_store(bar + i, 0u, __ATOMIC_RELAXED, __HIP_MEMORY_SCOPE_AGENT); }
    const size_t gtid = (size_t)bx * NTHREADS + tid, gthreads = (size_t)G * NTHREADS;
    cvt_rows(a.x, (bf16_t*)(ws + WS_XB2), (size_t)T * DM / 8, gtid, gthreads);
    cvt_rows(a.p, (bf16_t*)(ws + WS_PBF), (size_t)T * PLE / 8, gtid, gthreads);
    { GAS f32x4* st = (GAS f32x4*)(ws + WS_STATS); f32x4 zz = (f32x4){0.f, 0.f, 0.f, 0.f}; asm volatile("" : "+v"(zz)); for (size_t i = gtid; i < (size_t)4 * T * 2 / 4; i += gthreads) st[i] = zz;
      GAS float* lnp = (GAS float*)(ws + WS_LNP);
      for (size_t i = gtid; i < (size_t)4 * DM; i += gthreads) { const int l = (int)(i >> 11), c = (int)(i & 2047); lnp[(size_t)l * 4 * DM + c] = ((const GAS float*)a.ln_g)[i]; lnp[(size_t)l * 4 * DM + DM + c] = ((const GAS float*)a.ln_b)[i]; }
      GAS float* gp = (GAS float*)(ws + WS_GPART);
      for (size_t i = gtid; i < (size_t)16 * 4 * DM; i += gthreads) { const int c = (int)(i & 2047), l = (int)(i >> 11) & 3, ks = (int)(i >> 13);
          const GAS float* Gm = (const GAS float*)a.w_ple_gate + (size_t)l * DM * DM + (size_t)(ks * 128) * DM + c;
          const GAS float* gk = (const GAS float*)a.ln_g + l * DM + ks * 128; const GAS float* bk = (const GAS float*)a.ln_b + l * DM + ks * 128;
          float pg = 0.f, pb = 0.f;
#pragma unroll 8
          for (int k = 0; k < 128; ++k) { const float Gv = Gm[(size_t)k * DM]; pg += gk[k] * Gv; pb += bk[k] * Gv; }
          gp[((size_t)(ks * 4 + l) * 2 + 0) * DM + c] = pg; gp[((size_t)(ks * 4 + l) * 2 + 1) * DM + c] = pb; } }
    GAS f32x2* cs128 = (GAS f32x2*)(ws + WS_CS128); GAS f32x2* cs64 = (GAS f32x2*)(ws + WS_CS64);
    for (size_t i = gtid; i < (size_t)T * 64; i += gthreads) {
        const int tok = (int)(i >> 6), f = (int)(i & 63);
        const float ang = (float)((const GAS int*)a.pos)[tok] * ROPE_INV[f];
        const float n = rintf(ang * 0.15915494309189535f);
        float r = fmaf(-n, 6.2831854820251465f, ang); r = fmaf(-n, -1.7484555e-7f, r);
        const float c = __cosf(r), s = __sinf(r);
        cs128[i] = (f32x2){c, s};
        if ((f & 1) == 0) cs64[(size_t)tok * 32 + (f >> 1)] = (f32x2){c, s};
    }
}

__device__ __forceinline__ float relu_i(float x) { const int b = __float_as_int(x); return __int_as_float(b > 0 ? b : 0); }
__device__ __forceinline__ unsigned sortable(float f) { const unsigned u = __float_as_uint(f); return (u & 0x80000000u) ? ~u : (u | 0x80000000u); }
__device__ __forceinline__ void indexer_unit(const Args& a, LAS unsigned char* lds, int b, int t0, int wave, int lane) {
    const bf16_t* QI = (const bf16_t*)(a.ws + WS_QI); const bf16_t* KI = (const bf16_t*)(a.ws + WS_KI); const float* WI = (const float*)(a.ws + WS_WI);
    unsigned long long* MB = (unsigned long long*)(a.ws + WS_MB);
    const int l31 = lane & 31, hi = lane >> 5;
    const int tA = t0 + 2 * wave;
    const bf16_t* qrow = QI + (size_t)(b * SEQ + tA + (l31 >> 4)) * 1024 + (l31 & 15) * 64;
    bf16x8 qa[4];
#pragma unroll
    for (int kk = 0; kk < 4; ++kk) qa[kk] = *(const GAS bf16x8*)(qrow + kk * 16 + hi * 8);
    float w[16];
#pragma unroll
    for (int r = 0; r < 16; ++r) w[r] = ((const GAS float*)WI)[(size_t)(b * SEQ + tA + (r >> 3)) * 16 + (r & 3) + 8 * ((r >> 2) & 1) + 4 * hi];
    LAS float* sc = (LAS float*)lds + wave * 4096;
    const int npair = ((t0 + 15) / 32 + 2) / 2;
    const bf16_t* kbase = KI + (size_t)(b * SEQ + l31) * 64 + hi * 8;
    bf16x8 kA[8], kB[8], kC[8];
#define IDX_LOAD(dst, pr_) do { const int prc_ = (pr_) < npair ? (pr_) : npair - 1; _Pragma("unroll") for (int i = 0; i < 8; ++i) \
        dst[i] = *(const GAS bf16x8*)(kbase + (size_t)(prc_ * 64 + (i >> 2) * 32) * 64 + (i & 3) * 16); } while (0)
#define IDX_SCORE(kc, pr_) do { f32x16 acc0 = {}, acc1 = {}; \
        _Pragma("unroll") for (int kk = 0; kk < 4; ++kk) { acc0 = __builtin_amdgcn_mfma_f32_32x32x16_bf16(qa[kk], kc[kk], acc0, 0, 0, 0); acc1 = __builtin_amdgcn_mfma_f32_32x32x16_bf16(qa[kk], kc[4 + kk], acc1, 0, 0, 0); } \
        float s0 = 0.f, s1 = 0.f, s2 = 0.f, s3 = 0.f; \
        _Pragma("unroll") for (int r = 0; r < 8; ++r) { s0 += w[r] * relu_i(acc0[r]); s1 += w[r + 8] * relu_i(acc0[r + 8]); s2 += w[r] * relu_i(acc1[r]); s3 += w[r + 8] * relu_i(acc1[r + 8]); } \
        s0 = xor32_sum(s0); s1 = xor32_sum(s1); s2 = xor32_sum(s2); s3 = xor32_sum(s3); \
        if (hi == 0) { sc[(pr_) * 64 + l31] = s0; sc[(pr_) * 64 + 32 + l31] = s2; } else { sc[2048 + (pr_) * 64 + l31] = s1; sc[2048 + (pr_) * 64 + 32 + l31] = s3; } } while (0)
#pragma unroll
    for (int kk = 0; kk < 4; ++kk) asm volatile("" :: "v"(qa[kk]));
#pragma unroll
    for (int r = 0; r < 16; ++r) asm volatile("" :: "v"(w[r]));
    IDX_LOAD(kA, 0); IDX_LOAD(kB, 1);
    for (int pr = 0; pr < npair; pr += 3) {
        IDX_LOAD(kC, pr + 2);
        IDX_SCORE(kA, pr);
        IDX_LOAD(kA, pr + 3);
        if (pr + 1 < npair) IDX_SCORE(kB, pr + 1);
        IDX_LOAD(kB, pr + 4);
        if (pr + 2 < npair) IDX_SCORE(kC, pr + 2);
    }
#undef IDX_LOAD
#undef IDX_SCORE
    const int tB = tA + 1;
    unsigned uA[32], uB[32];
#pragma unroll
    for (int i = 0; i < 32; ++i) { const int key = lane + 64 * i; const unsigned xa = sortable(sc[key]), xb = sortable(sc[2048 + key]); uA[i] = key <= tA ? xa : 0u; uB[i] = key <= tB ? xb : 0u; }
    const int ng = (tB >> 9) + 1;
    unsigned thrA = 1u, thrB = 1u;
    for (int prb = 0; prb < PROBE_SEL_REPS; ++prb) {
    asm volatile("" : "+s"(thrA), "+s"(thrB));
    if (tB + 1 > 256) {
        thrA = 0u; thrB = 0u;
#pragma unroll 1
        for (int bit = 31; bit >= 0; --bit) {
            const unsigned candA = thrA | (1u << bit), candB = thrB | (1u << bit);
            int cntA = 0, cntB = 0;
#pragma unroll
            for (int g = 0; g < 4; ++g) if (g < ng) {
#pragma unroll
                for (int i = 8 * g; i < 8 * g + 8; ++i) { cntA += __builtin_popcountll(__ballot(uA[i] >= candA)); cntB += __builtin_popcountll(__ballot(uB[i] >= candB)); }
            }
            if (cntA >= 256) thrA = candA;
            if (cntB >= 256) thrB = candB;
        }
        if (tA + 1 <= 256) thrA = 1u;
        if (thrA == 0u) thrA = 1u;
        if (thrB == 0u) thrB = 1u;
    }
    }
    unsigned long long mineA = 0ull, mineB = 0ull;
#pragma unroll
    for (int i = 0; i < 32; ++i) { const unsigned long long ba = __ballot(uA[i] >= thrA), bb = __ballot(uB[i] >= thrB); if (lane == i) { mineA = ba; mineB = bb; } }
    if (lane < 32) { ((GAS unsigned long long*)MB)[(size_t)(b * SEQ + tA) * 32 + lane] = mineA; ((GAS unsigned long long*)MB)[(size_t)(b * SEQ + tB) * 32 + lane] = mineB; }
}
__device__ __forceinline__ void indexer_phase(const Args& a, LAS unsigned char* lds, int bx, int G, int wave, int lane) {
    for (int L = bx; L < 2048; L += G) {
        const int i = L >> 8, c = L & 255;
        const int b = (c >> 7) + 2 * i;
        const int tb = (i & 1) ? 127 - (c & 127) : (c & 127);
        indexer_unit(a, lds, b, tb * 16, wave, lane);
    }
}

constexpr int KPITCH = 272, VPITCH = 144, KTILE_B = 64 * KPITCH, VTILE_B = 128 * VPITCH, ABUF_B = KTILE_B + VTILE_B;

template <bool MASKED>
__device__ __forceinline__ void stick_half(f32x16& p, const int d, float& R, const int hi) {
    float lk[16];
#pragma unroll
    for (int r = 0; r < 16; ++r) { const float z = p[r]; const float e = __builtin_amdgcn_exp2f(-fabsf(z)); const float sp = relu_i(z) + __builtin_amdgcn_logf(1.0f + e);
        if (MASKED) { const bool valid = ((r & 3) + 8 * (r >> 2)) < d; lk[r] = valid ? -sp : 0.f; p[r] = valid ? z - sp : -__builtin_inff(); }
        else { lk[r] = -sp; p[r] = z - sp; } }
    float Gs[4], Ps[4], Tt[4];
#pragma unroll
    for (int g = 0; g < 4; ++g) { Gs[g] = (lk[4 * g] + lk[4 * g + 1]) + (lk[4 * g + 2] + lk[4 * g + 3]); Ps[g] = xor32_get(Gs[g], hi); Tt[g] = Gs[g] + Ps[g]; }
    float later[4];
    later[3] = 0.f; later[2] = Tt[3]; later[1] = Tt[3] + Tt[2]; later[0] = later[1] + Tt[1];
#pragma unroll
    for (int g = 0; g < 4; ++g) { const float base = R + later[g] + (hi == 0 ? Ps[g] : 0.f);
        const float e2 = lk[4 * g + 3], e1 = e2 + lk[4 * g + 2], e0 = e1 + lk[4 * g + 1];
        p[4 * g + 3] = __builtin_amdgcn_exp2f(p[4 * g + 3] + base); p[4 * g + 2] = __builtin_amdgcn_exp2f(p[4 * g + 2] + base + e2);
        p[4 * g + 1] = __builtin_amdgcn_exp2f(p[4 * g + 1] + base + e1); p[4 * g] = __builtin_amdgcn_exp2f(p[4 * g] + base + e0); }
    R += (Tt[0] + Tt[1]) + (Tt[2] + Tt[3]);
}

template <bool STICK>
__device__ __forceinline__ void attn_unit(LAS unsigned char* lds, const bf16_t* Qw, const bf16_t* Kg, int kpitch, const bf16_t* Vtg, const unsigned long long* MBrow,
                                          const bf16_t* SGw, bf16_t* Ow, int tq, int tmax_wave, int ntiles, int tid, int lane) {
    const int l31 = lane & 31, hi = lane >> 5;
    bf16x8 qf[8];
#pragma unroll
    for (int kk = 0; kk < 8; ++kk) qf[kk] = *(const GAS bf16x8*)(Qw + (size_t)l31 * DM + kk * 16 + hi * 8);
    f32x16 o[4];
#pragma unroll
    for (int dc = 0; dc < 4; ++dc) o[dc] = (f32x16){};
    float mrun = -__builtin_inff(), lsum = 0.f, R = 0.f;
    const int kr0 = tid >> 4, kc0 = tid & 15;
    const int vd0 = tid >> 3, vc0 = tid & 7;
    const int vco = (vc0 >> 1) * 32 + (vc0 & 1) * 8;
    u32x4 kreg[2], vreg[2];
#define ATT_LOAD(kt) do { const int key0_ = (kt) * 64; \
        kreg[0] = *(const GAS u32x4*)(Kg + (size_t)(key0_ + kr0) * kpitch + kc0 * 8); kreg[1] = *(const GAS u32x4*)(Kg + (size_t)(key0_ + kr0 + 32) * kpitch + kc0 * 8); \
        vreg[0] = *(const GAS u32x4*)(Vtg + (size_t)vd0 * T + key0_ + vc0 * 8); vreg[1] = *(const GAS u32x4*)(Vtg + (size_t)(vd0 + 64) * T + key0_ + vc0 * 8); } while (0)
#define ATT_STORE(buf) do { LAS unsigned char* kb_ = lds + (buf) * ABUF_B; LAS unsigned char* vb_ = kb_ + KTILE_B; \
        *(LAS u32x4*)(kb_ + kr0 * KPITCH + kc0 * 16) = kreg[0]; *(LAS u32x4*)(kb_ + (kr0 + 32) * KPITCH + kc0 * 16) = kreg[1]; \
        *(LAS u32x2*)(vb_ + vd0 * VPITCH + vco) = (u32x2){vreg[0].x, vreg[0].y}; *(LAS u32x2*)(vb_ + vd0 * VPITCH + vco + 16) = (u32x2){vreg[0].z, vreg[0].w}; \
        *(LAS u32x2*)(vb_ + (vd0 + 64) * VPITCH + vco) = (u32x2){vreg[1].x, vreg[1].y}; *(LAS u32x2*)(vb_ + (vd0 + 64) * VPITCH + vco + 16) = (u32x2){vreg[1].z, vreg[1].w}; } while (0)
#pragma unroll
    for (int kk = 0; kk < 8; ++kk) asm volatile("" :: "v"(qf[kk]));
    unsigned long long mb_next = 0ull;
    if (!STICK) mb_next = ((const GAS unsigned long long*)MBrow)[0];
    ATT_LOAD(STICK ? ntiles - 1 : 0);
    ATT_STORE(0);
    __syncthreads();
    for (int it = 0; it < ntiles; ++it) {
        const int kt = STICK ? ntiles - 1 - it : it;
        const int key0 = kt * 64;
        const unsigned long long mb = mb_next;
        if (!STICK && it + 1 < ntiles) mb_next = ((const GAS unsigned long long*)MBrow)[kt + 1];
        if (it + 1 < ntiles) ATT_LOAD(STICK ? kt - 1 : kt + 1);
        const LAS unsigned char* kb = lds + (it & 1) * ABUF_B; const LAS unsigned char* vb = kb + KTILE_B;
        const bool active = STICK ? (key0 < tmax_wave && !__all(R < -151.0f)) : true;
        if (active) {
            f32x16 p0 = {}, p1 = {};
            if (!STICK) {
                const unsigned nlo = ~((unsigned)mb >> (4 * hi)), nhi = ~((unsigned)(mb >> 32) >> (4 * hi));
#pragma unroll
                for (int r = 0; r < 16; ++r) { const int bp = (r & 3) + 8 * (r >> 2);
                    p0[r] = __int_as_float(sbfe1(nlo, bp) & (int)0xFF800000); p1[r] = __int_as_float(sbfe1(nhi, bp) & (int)0xFF800000); }
            }
#pragma unroll
            for (int kh = 0; kh < 2; ++kh) {
                bf16x8 kfa[4], kfb[4];
#pragma unroll
                for (int k4 = 0; k4 < 4; ++k4) { const int kk = kh * 4 + k4; kfa[k4] = *(const LAS bf16x8*)(kb + l31 * KPITCH + kk * 32 + hi * 16); kfb[k4] = *(const LAS bf16x8*)(kb + (32 + l31) * KPITCH + kk * 32 + hi * 16); }
                __builtin_amdgcn_sched_barrier(0);
                __builtin_amdgcn_s_setprio(1);
#pragma unroll
                for (int k4 = 0; k4 < 4; ++k4) { const int kk = kh * 4 + k4; p0 = __builtin_amdgcn_mfma_f32_32x32x16_bf16(kfa[k4], qf[kk], p0, 0, 0, 0); p1 = __builtin_amdgcn_mfma_f32_32x32x16_bf16(kfb[k4], qf[kk], p1, 0, 0, 0); }
                __builtin_amdgcn_s_setprio(0);
                __builtin_amdgcn_sched_barrier(0);
            }
            if (!STICK) {
                const float NEG = -__builtin_inff();
                float mx = NEG;
#pragma unroll
                for (int r = 0; r < 16; ++r) mx = max3f(mx, p0[r], p1[r]);
                mx = xor32_max(mx);
                const float mnew = fmaxf(mrun, mx);
                const float msafe = (mnew == NEG) ? 0.f : mnew;
                const float alpha = __builtin_amdgcn_exp2f(mrun - msafe);
                float ps = 0.f;
#pragma unroll
                for (int r = 0; r < 16; ++r) { p0[r] = __builtin_amdgcn_exp2f(p0[r] - msafe); p1[r] = __builtin_amdgcn_exp2f(p1[r] - msafe); ps += p0[r] + p1[r]; }
                lsum = lsum * alpha + ps;
                mrun = mnew;
                if (!__all(alpha == 1.0f)) {
#pragma unroll
                    for (int dc = 0; dc < 4; ++dc)
#pragma unroll
                        for (int r = 0; r < 16; ++r) o[dc][r] *= alpha;
                }
            } else {
#pragma unroll
                for (int h32 = 1; h32 >= 0; --h32) stick_half<true>(h32 ? p1 : p0, tq - (key0 + 32 * h32 + 4 * hi), R, hi);
            }
            bf16x8 pf[4];
#pragma unroll
            for (int j = 0; j < 4; ++j) { const f32x16& p = (j >> 1) ? p1 : p0; const int r0 = 8 * (j & 1);
                u32x4 w; w.x = cvt_pk_bf16(p[r0], p[r0 + 1]); w.y = cvt_pk_bf16(p[r0 + 2], p[r0 + 3]); w.z = cvt_pk_bf16(p[r0 + 4], p[r0 + 5]); w.w = cvt_pk_bf16(p[r0 + 6], p[r0 + 7]);
                pf[j] = __builtin_bit_cast(bf16x8, w); }
#pragma unroll
            for (int j = 0; j < 4; ++j) {
                u32x4 vv[4];
#pragma unroll
                for (int dc = 0; dc < 4; ++dc) vv[dc] = *(const LAS u32x4*)(vb + (32 * dc + l31) * VPITCH + 32 * j + 16 * hi);
                __builtin_amdgcn_sched_barrier(0);
                __builtin_amdgcn_s_setprio(1);
#pragma unroll
                for (int dc = 0; dc < 4; ++dc) o[dc] = __builtin_amdgcn_mfma_f32_32x32x16_bf16(__builtin_bit_cast(bf16x8, vv[dc]), pf[j], o[dc], 0, 0, 0);
                __builtin_amdgcn_s_setprio(0);
                __builtin_amdgcn_sched_barrier(0);
            }
        }
        if (it + 1 < ntiles) ATT_STORE((it + 1) & 1);
        if (STICK) {
            const int allneg = __all(R < -151.0f);
            if (lane == 0) ((volatile LAS int*)(lds + 2 * ABUF_B))[(it & 1) * 8 + (tid >> 6)] = allneg;
        }
        __syncthreads();
        if (STICK) {
            const volatile LAS int* fl = (const volatile LAS int*)(lds + 2 * ABUF_B) + (it & 1) * 8;
            int done = fl[0] & fl[1] & fl[2] & fl[3] & fl[4] & fl[5] & fl[6] & fl[7];
            if (done) break;
        }
    }
#undef ATT_LOAD
#undef ATT_STORE
    float inv = 1.0f;
    if (!STICK) { lsum = xor32_sum(lsum); inv = 1.0f / lsum; }
    u32x2 sgv[16];
#pragma unroll
    for (int i = 0; i < 16; ++i) sgv[i] = *(const GAS u32x2*)(SGw + (size_t)l31 * DM + 32 * (i >> 2) + 8 * (i & 3) + 4 * hi);
#pragma unroll
    for (int dc = 0; dc < 4; ++dc)
#pragma unroll
        for (int g = 0; g < 4; ++g) {
            const size_t off = (size_t)l31 * DM + 32 * dc + 8 * g + 4 * hi;
            const u32x2 sg = sgv[dc * 4 + g];
            u32x2 w;
            w.x = cvt_pk_bf16(o[dc][4 * g] * inv * bf_lo(sg.x), o[dc][4 * g + 1] * inv * bf_hi(sg.x));
            w.y = cvt_pk_bf16(o[dc][4 * g + 2] * inv * bf_lo(sg.y), o[dc][4 * g + 3] * inv * bf_hi(sg.y));
            *(GAS u32x2*)(Ow + off) = w;
        }
}

__device__ __forceinline__ void attn_unit_a(LAS unsigned char* lds, const bf16_t* Qw, const bf16_t* Kg, int kpitch, const bf16_t* Vtg, const unsigned long long* MBrow,
                                            const bf16_t* SGw, bf16_t* Ow, int ntiles, int tid, int lane) {
    const int l31 = lane & 31, hi = lane >> 5;
    const bool lag = tid >= 256;
    bf16x8 qf[8];
#pragma unroll
    for (int kk = 0; kk < 8; ++kk) qf[kk] = *(const GAS bf16x8*)(Qw + (size_t)l31 * DM + kk * 16 + hi * 8);
    f32x16 o[4];
#pragma unroll
    for (int dc = 0; dc < 4; ++dc) o[dc] = (f32x16){};
    float mrun = -__builtin_inff(), lsum = 0.f;
    const int kr0 = tid >> 4, kc0 = tid & 15, vd0 = tid >> 3, vc0 = tid & 7, vco = (vc0 >> 1) * 32 + (vc0 & 1) * 8;
    u32x4 kregA[2], vregA[2], kregB[2], vregB[2];
#define ATA_LOAD(kreg, vreg, kt) do { const int key0_ = (kt) * 64; \
        kreg[0] = *(const GAS u32x4*)(Kg + (size_t)(key0_ + kr0) * kpitch + kc0 * 8); kreg[1] = *(const GAS u32x4*)(Kg + (size_t)(key0_ + kr0 + 32) * kpitch + kc0 * 8); \
        vreg[0] = *(const GAS u32x4*)(Vtg + (size_t)vd0 * T + key0_ + vc0 * 8); vreg[1] = *(const GAS u32x4*)(Vtg + (size_t)(vd0 + 64) * T + key0_ + vc0 * 8); } while (0)
#define ATA_STORE(kreg, vreg, buf) do { LAS unsigned char* kb_ = lds + (buf) * ABUF_B; LAS unsigned char* vb_ = kb_ + KTILE_B; \
        *(LAS u32x4*)(kb_ + kr0 * KPITCH + kc0 * 16) = kreg[0]; *(LAS u32x4*)(kb_ + (kr0 + 32) * KPITCH + kc0 * 16) = kreg[1]; \
        *(LAS u32x2*)(vb_ + vd0 * VPITCH + vco) = (u32x2){vreg[0].x, vreg[0].y}; *(LAS u32x2*)(vb_ + vd0 * VPITCH + vco + 16) = (u32x2){vreg[0].z, vreg[0].w}; \
        *(LAS u32x2*)(vb_ + (vd0 + 64) * VPITCH + vco) = (u32x2){vreg[1].x, vreg[1].y}; *(LAS u32x2*)(vb_ + (vd0 + 64) * VPITCH + vco + 16) = (u32x2){vreg[1].z, vreg[1].w}; } while (0)
    f32x16 p0 = {}, p1 = {};
#define ATA_QK(kb, mb) do { \
        const unsigned nlo = ~((unsigned)(mb) >> (4 * hi)), nhi = ~((unsigned)((mb) >> 32) >> (4 * hi)); \
        _Pragma("unroll") for (int r = 0; r < 16; ++r) { const int bp = (r & 3) + 8 * (r >> 2); \
            p0[r] = __int_as_float(sbfe1(nlo, bp) & (int)0xFF800000); p1[r] = __int_as_float(sbfe1(nhi, bp) & (int)0xFF800000); } \
        _Pragma("unroll") for (int kh = 0; kh < 2; ++kh) { bf16x8 kfa[4], kfb[4]; \
            _Pragma("unroll") for (int k4 = 0; k4 < 4; ++k4) { const int kk = kh * 4 + k4; kfa[k4] = *(const LAS bf16x8*)((kb) + l31 * KPITCH + kk * 32 + hi * 16); kfb[k4] = *(const LAS bf16x8*)((kb) + (32 + l31) * KPITCH + kk * 32 + hi * 16); } \
            __builtin_amdgcn_sched_barrier(0); __builtin_amdgcn_s_setprio(1); \
            _Pragma("unroll") for (int k4 = 0; k4 < 4; ++k4) { const int kk = kh * 4 + k4; p0 = __builtin_amdgcn_mfma_f32_32x32x16_bf16(kfa[k4], qf[kk], p0, 0, 0, 0); p1 = __builtin_amdgcn_mfma_f32_32x32x16_bf16(kfb[k4], qf[kk], p1, 0, 0, 0); } \
            __builtin_amdgcn_s_setprio(0); __builtin_amdgcn_sched_barrier(0); } } while (0)
#define ATA_SMPV(vb) do { \
        const float NEG = -__builtin_inff(); float mx = NEG; \
        _Pragma("unroll") for (int r = 0; r < 16; ++r) mx = max3f(mx, p0[r], p1[r]); \
        mx = xor32_max(mx); \
        const float mnew = fmaxf(mrun, mx); const float msafe = (mnew == NEG) ? 0.f : mnew; const float alpha = __builtin_amdgcn_exp2f(mrun - msafe); \
        float ps = 0.f; \
        _Pragma("unroll") for (int r = 0; r < 16; ++r) { p0[r] = __builtin_amdgcn_exp2f(p0[r] - msafe); p1[r] = __builtin_amdgcn_exp2f(p1[r] - msafe); ps += p0[r] + p1[r]; } \
        lsum = lsum * alpha + ps; mrun = mnew; \
        if (!__all(alpha == 1.0f)) { _Pragma("unroll") for (int dc = 0; dc < 4; ++dc) _Pragma("unroll") for (int r = 0; r < 16; ++r) o[dc][r] *= alpha; } \
        bf16x8 pf[4]; \
        _Pragma("unroll") for (int j = 0; j < 4; ++j) { const f32x16& p = (j >> 1) ? p1 : p0; const int r0 = 8 * (j & 1); \
            u32x4 w; w.x = cvt_pk_bf16(p[r0], p[r0 + 1]); w.y = cvt_pk_bf16(p[r0 + 2], p[r0 + 3]); w.z = cvt_pk_bf16(p[r0 + 4], p[r0 + 5]); w.w = cvt_pk_bf16(p[r0 + 6], p[r0 + 7]); \
            pf[j] = __builtin_bit_cast(bf16x8, w); } \
        _Pragma("unroll") for (int j = 0; j < 4; ++j) { u32x4 vv[4]; \
            _Pragma("unroll") for (int dc = 0; dc < 4; ++dc) vv[dc] = *(const LAS u32x4*)((vb) + (32 * dc + l31) * VPITCH + 32 * j + 16 * hi); \
            __builtin_amdgcn_sched_barrier(0); __builtin_amdgcn_s_setprio(1); \
            _Pragma("unroll") for (int dc = 0; dc < 4; ++dc) o[dc] = __builtin_amdgcn_mfma_f32_32x32x16_bf16(__builtin_bit_cast(bf16x8, vv[dc]), pf[j], o[dc], 0, 0, 0); \
            __builtin_amdgcn_s_setprio(0); __builtin_amdgcn_sched_barrier(0); } } while (0)
#pragma unroll
    for (int kk = 0; kk < 8; ++kk) asm volatile("" :: "v"(qf[kk]));
    unsigned long long mb_next = ((const GAS unsigned long long*)MBrow)[0];
    ATA_LOAD(kregA, vregA, 0);
    ATA_STORE(kregA, vregA, 0);
    if (ntiles > 1) ATA_LOAD(kregA, vregA, 1);
    __syncthreads();
    int b_prev = 2, b_cur = 0, b_next = 1;
#define ATA_STEP(t, kL, vL, kS, vS) do { \
        const unsigned long long mb = mb_next; \
        if ((t) + 1 < ntiles) mb_next = ((const GAS unsigned long long*)MBrow)[(t) + 1]; \
        if ((t) + 2 < ntiles) ATA_LOAD(kL, vL, (t) + 2); \
        const LAS unsigned char* kb = lds + b_cur * ABUF_B; \
        if (!lag) { ATA_QK(kb, mb); ATA_SMPV(kb + KTILE_B); } \
        else { if ((t) > 0) ATA_SMPV(lds + b_prev * ABUF_B + KTILE_B); ATA_QK(kb, mb); } \
        if ((t) + 1 < ntiles) ATA_STORE(kS, vS, b_next); \
        __syncthreads(); \
        b_prev = b_cur; b_cur = b_next; b_next = (b_next == 2) ? 0 : b_next + 1; } while (0)
    for (int it = 0; it < ntiles; it += 2) {
        ATA_STEP(it, kregB, vregB, kregA, vregA);
        if (it + 1 < ntiles) ATA_STEP(it + 1, kregA, vregA, kregB, vregB);
    }
#undef ATA_STEP
    if (lag) ATA_SMPV(lds + b_prev * ABUF_B + KTILE_B);
#undef ATA_LOAD
#undef ATA_STORE
#undef ATA_QK
#undef ATA_SMPV
    lsum = xor32_sum(lsum);
    const float inv = 1.0f / lsum;
    u32x2 sgv[16];
#pragma unroll
    for (int i = 0; i < 16; ++i) sgv[i] = *(const GAS u32x2*)(SGw + (size_t)l31 * DM + 32 * (i >> 2) + 8 * (i & 3) + 4 * hi);
#pragma unroll
    for (int dc = 0; dc < 4; ++dc)
#pragma unroll
        for (int g = 0; g < 4; ++g) {
            const size_t off = (size_t)l31 * DM + 32 * dc + 8 * g + 4 * hi;
            const u32x2 sg = sgv[dc * 4 + g];
            u32x2 w;
            w.x = cvt_pk_bf16(o[dc][4 * g] * inv * bf_lo(sg.x), o[dc][4 * g + 1] * inv * bf_hi(sg.x));
            w.y = cvt_pk_bf16(o[dc][4 * g + 2] * inv * bf_lo(sg.y), o[dc][4 * g + 3] * inv * bf_hi(sg.y));
            *(GAS u32x2*)(Ow + off) = w;
        }
    __syncthreads();
}

__device__ __forceinline__ int vcu_of(int bx, int G) { return (G % 8 == 0) ? (bx % 8) * (G / 8) + bx / 8 : bx; }

__device__ __forceinline__ void attn_a_phase(const Args& a, LAS unsigned char* lds, int bx, int G, int tid, int wave, int lane) {
    const int v = vcu_of(bx, G);
    bf16_t* QO = (bf16_t*)(a.ws + WS_QO); const bf16_t* KA = (const bf16_t*)(a.ws + WS_KA); const bf16_t* VTA = (const bf16_t*)(a.ws + WS_VTA);
    const bf16_t* SG = (const bf16_t*)(a.ws + WS_SGP); const unsigned long long* MB = (const unsigned long long*)(a.ws + WS_MB);
    for (int L = v; L < 2048; L += G) {
        const int i = L >> 8, c = L & 255;
        const int bk = (c >> 5) + 8 * i, b = bk >> 2, kvh = bk & 3;
        const int qb = (i & 1) ? 31 - (c & 31) : (c & 31);
        const int head = kvh * 4 + (wave >> 1);
        const int trow = qb * 64 + (wave & 1) * 32;
        const size_t tok0 = (size_t)b * SEQ + trow;
        bf16_t* Qw = QO + tok0 * DM + head * HD;
        attn_unit_a(lds, Qw, KA + (size_t)b * SEQ * 512 + kvh * HD, 512, VTA + (size_t)(kvh * HD) * T + (size_t)b * SEQ,
                    MB + (tok0 + (lane & 31)) * 32, SG + tok0 * DM + head * HD, (bf16_t*)(a.ws + WS_XB1) + tok0 * DM + head * HD, qb + 1, tid, lane);
    }
}
__device__ __forceinline__ void attn_b_phase(const Args& a, LAS unsigned char* lds, int bx, int G, int tid, int wave, int lane) {
    const int v = vcu_of(bx, G);
    bf16_t* QO = (bf16_t*)(a.ws + WS_QO); const bf16_t* KB = (const bf16_t*)(a.ws + WS_KB); const bf16_t* VTB = (const bf16_t*)(a.ws + WS_VTB);
    const bf16_t* SG = (const bf16_t*)(a.ws + WS_SGP);
    for (int L = v; L < 2048; L += G) {
        const int i = L >> 8, c = L & 255;
        const int bh = (c >> 3) + 32 * i, b = bh >> 4, h = bh & 15;
        const int qb = (i & 1) ? 7 - (c & 7) : (c & 7);
        const int trow = qb * 256 + wave * 32;
        const size_t tok0 = (size_t)b * SEQ + trow;
        bf16_t* Qw = QO + tok0 * DM + h * HD;
        attn_unit<true>(lds, Qw, KB + (size_t)b * SEQ * DM + h * HD, DM, VTB + (size_t)(h * HD) * T + (size_t)b * SEQ,
                        nullptr, SG + tok0 * DM + h * HD, (bf16_t*)(a.ws + WS_XB1) + tok0 * DM + h * HD, trow + (lane & 31), trow + 31, 4 * qb + 4, tid, lane);
    }
}

constexpr int NPHASES = 19;
enum { K_PRO = 0, K_INA, K_IDX, K_ATA, K_OUT, K_GATE, K_QGB, K_ATB };

__global__ void __launch_bounds__(NTHREADS, 2) fwd_megakernel(Args a0) {
    extern __shared__ __attribute__((aligned(16))) unsigned char lds_raw[];
    LAS unsigned char* lds = (LAS unsigned char*)lds_raw;
    const int ph_lo = a0.ph_lo, ph_hi = a0.ph_hi;
    const int wave0 = __builtin_amdgcn_readfirstlane(threadIdx.x >> 6);
    if (threadIdx.x == 0) { ((volatile LAS unsigned*)(lds + LDS_BARST))[0] = 0u; ((volatile LAS unsigned*)(lds + LDS_BARST))[1] = 0u; }
    __syncthreads();
    for (int ph = ph_lo; ph < ph_hi; ++ph) {
        int kind, layer;
        if (ph == 0) { kind = K_PRO; layer = 0; }
        else if (ph < 11) { layer = (ph - 1) / 5; const int s = (ph - 1) % 5; kind = s == 0 ? K_INA : s == 1 ? K_IDX : s == 2 ? K_ATA : s == 3 ? K_OUT : K_GATE; }
        else { layer = 2 + (ph - 11) / 4; const int s = (ph - 11) % 4; kind = s == 0 ? K_QGB : s == 1 ? K_ATB : s == 2 ? K_OUT : K_GATE; }
        const int reps = (kind == PROBE_REPEAT_KIND) ? 2 : 1;
        for (int rep = 0; rep < reps; ++rep) {
        if (rep) xcd_barrier((unsigned*)(a0.ws + WS_BAR), (volatile LAS unsigned*)(lds + LDS_BARST), (int)threadIdx.x, gridDim.x);
        int lane; asm volatile("v_mbcnt_lo_u32_b32 %0, -1, 0\n\tv_mbcnt_hi_u32_b32 %0, -1, %0" : "=v"(lane));
        int wave = wave0; asm volatile("" : "+s"(wave));
        const int tid = wave * 64 + lane;
        int bx = blockIdx.x, G = gridDim.x; asm volatile("" : "+s"(bx), "+s"(G));
        Args a = a0;
        asm volatile("" : "+s"(a.out), "+s"(a.ws));
        unsigned char* ws = a.ws;
        if (kind == K_PRO) {
#ifndef NO_PRO
            asm volatile("" : "+s"(a.x), "+s"(a.p), "+s"(a.pos), "+s"(a.w_in_a), "+s"(a.w_out_a), "+s"(a.w_q_b), "+s"(a.w_kv_b));
            asm volatile("" : "+s"(a.w_out_b), "+s"(a.w_ple), "+s"(a.w_ple_gate), "+s"(a.ln_g), "+s"(a.ln_b));
            prologue(a, lds, bx, G, tid, wave, lane);
#endif
        } else if (kind == K_IDX) {
#ifndef NO_IDX
            indexer_phase(a, lds, bx, G, wave, lane);
#endif
        } else if (kind == K_ATA) {
#ifndef NO_ATA
            attn_a_phase(a, lds, bx, G, tid, wave, lane);
#endif
        } else if (kind == K_ATB) {
#ifndef NO_ATB
            attn_b_phase(a, lds, bx, G, tid, wave, lane);
#endif
        } else {
#ifndef NO_GEMM
            if (kind == K_INA && layer == 0) {
                const GAS float* gp = (const GAS float*)(ws + WS_GPART); GAS float* lnp = (GAS float*)(ws + WS_LNP);
                for (int i = bx * NTHREADS + tid; i < 4 * 2 * DM; i += G * NTHREADS) { const int c = i & 2047, which = (i >> 11) & 1, l = i >> 12; float sum = 0.f;
#pragma unroll
                    for (int ks = 0; ks < 16; ++ks) sum += gp[((size_t)(ks * 4 + l) * 2 + which) * DM + c];
                    lnp[(size_t)l * 4 * DM + (2 + which) * DM + c] = sum; }
            }
            const int njobs = (kind == K_INA || kind == K_OUT) ? 2 : (kind == K_QGB && layer == 2) ? 3 : 1;
            for (int j = 0; j < njobs; ++j) {
                pg8::Gemm g; pg8::Epi E; E.ws = ws; E.xin = nullptr; E.xf = a.out; E.O = nullptr; E.ldc = 0; E.ymul = 1.0f; E.mode = pg8::MODE_PLAIN; E.layer = layer;
                const bf16_t* xb2 = (const bf16_t*)(ws + WS_XB2);
                if (kind == K_INA) {
                    const bf16_t* W = (const bf16_t*)(ws + WS_WINA) + (size_t)layer * AWP * DM;
                    if (j == 0) { g = pg8::Gemm{xb2, W, T, ANP, DM}; E.mode = pg8::MODE_INA; }
                    else { g = pg8::Gemm{W + (size_t)ANP * DM, xb2, 512, T, DM}; E.O = (bf16_t*)(ws + WS_VTA); E.ldc = T; }
                } else if (kind == K_OUT) {
                    if (j == 0) { const bf16_t* W = layer < 2 ? (const bf16_t*)(ws + WS_WOUTA) + (size_t)layer * DM * DM : (const bf16_t*)(ws + WS_WOUTB) + (size_t)(layer - 2) * DM * DM;
                        g = pg8::Gemm{(const bf16_t*)(ws + WS_XB1), W, T, DM, DM}; E.mode = pg8::MODE_OUT; const float* xin0 = a.x; asm volatile("" : "+s"(xin0)); E.xin = layer == 0 ? xin0 : a.out; E.ymul = layer < 2 ? DBG_YMUL_A : DBG_YMUL_B; }
                    else { g = pg8::Gemm{(const bf16_t*)(ws + WS_PBF), (const bf16_t*)(ws + WS_WPLE) + (size_t)layer * DM * PLE, T, DM, PLE}; E.O = (bf16_t*)(ws + WS_SGP); E.ldc = DM; }
                } else if (kind == K_GATE) {
                    g = pg8::Gemm{(const bf16_t*)(ws + WS_QO), (const bf16_t*)(ws + WS_WG) + (size_t)layer * DM * DM, T, DM, DM}; E.mode = pg8::MODE_GATE;
                } else {
                    const bf16_t* Wkv = (const bf16_t*)(ws + WS_WKV);
                    if (j == 0) { g = pg8::Gemm{xb2, (const bf16_t*)(ws + WS_WQB) + (size_t)(layer - 2) * 4096 * DM, T, 4096, DM}; E.mode = pg8::MODE_QG; }
                    else if (j == 1) { g = pg8::Gemm{xb2, Wkv, T, DM, DM}; E.O = (bf16_t*)(ws + WS_KB); E.ldc = DM; }
                    else { g = pg8::Gemm{Wkv + (size_t)DM * DM, xb2, DM, T, DM}; E.O = (bf16_t*)(ws + WS_VTB); E.ldc = T; }
                }
                pg8::StaticOrder S; S.init(g.M, g.N, G, bx);
                pg8::gemm_phase<pg8::Epi, pg8::StaticOrder>(lds, g, S, E, wave);
            }
            if (kind == K_GATE && layer + 1 < 4) {
                const float* pp = a.p; asm volatile("" : "+s"(pp));
                int lane2; asm volatile("v_mbcnt_lo_u32_b32 %0, -1, 0\n\tv_mbcnt_hi_u32_b32 %0, -1, %0" : "=v"(lane2));
                cvt_rows(pp + (size_t)(layer + 1) * T * PLE, (bf16_t*)(ws + WS_PBF), (size_t)T * PLE / 8, (size_t)bx * NTHREADS + wave * 64 + lane2, (size_t)G * NTHREADS);
            }
#endif
        }
        }
        if (ph + 1 < ph_hi) {
            if (ph == 0) { cg::this_grid().sync(); if (threadIdx.x == 0) (void)xb_add((unsigned*)(a0.ws + WS_BAR) + XB_XCNT(xb_xcc_id()), 1u); }
            else xcd_barrier((unsigned*)(a0.ws + WS_BAR), (volatile LAS unsigned*)(lds + LDS_BARST), (int)threadIdx.x, gridDim.x);
            for (int e = 0; ph == 1 && e < PROBE_EXTRA_SYNCS; ++e) xcd_barrier((unsigned*)(a0.ws + WS_BAR), (volatile LAS unsigned*)(lds + LDS_BARST), (int)threadIdx.x, gridDim.x);
        }
    }
}

extern "C" void kernel_launch(void* const* d_in, const int* in_sizes, int n_in, void* d_out, int out_size, void* d_ws, size_t ws_size, hipStream_t stream) {
    static int grid = 0;
    if (grid == 0) {
        if (n_in != 12 || out_size != T * DM || ws_size < WS_END) { fprintf(stderr, "kernel_launch: unexpected shapes (n_in %d out %d ws %zu); nothing launched\n", n_in, out_size, ws_size); grid = -1; return; }
        int dev = 0, cus = 0, per_cu = 0;
        if (hipGetDevice(&dev) != hipSuccess || hipDeviceGetAttribute(&cus, hipDeviceAttributeMultiprocessorCount, dev) != hipSuccess) { grid = -1; return; }
        if (hipFuncSetAttribute((const void*)fwd_megakernel, hipFuncAttributeMaxDynamicSharedMemorySize, LDS_BYTES) != hipSuccess) { fprintf(stderr, "kernel_launch: hipFuncSetAttribute failed\n"); grid = -1; return; }
        if (hipOccupancyMaxActiveBlocksPerMultiprocessor(&per_cu, (const void*)fwd_megakernel, NTHREADS, LDS_BYTES) != hipSuccess || per_cu < 1) { fprintf(stderr, "kernel_launch: occupancy query says %d\n", per_cu); per_cu = 1; }
        (void)hipGetLastError();
        grid = cus * 1;
    }
    if (grid < 0) return;
    Args a{};
    a.x = (const float*)d_in[0]; a.p = (const float*)d_in[1]; a.pos = (const int*)d_in[2]; a.w_in_a = (const float*)d_in[3]; a.w_out_a = (const float*)d_in[4];
    a.w_q_b = (const float*)d_in[5]; a.w_kv_b = (const float*)d_in[6]; a.w_out_b = (const float*)d_in[7]; a.ln_g = (const float*)d_in[8]; a.ln_b = (const float*)d_in[9];
    a.w_ple = (const float*)d_in[10]; a.w_ple_gate = (const float*)d_in[11]; a.out = (float*)d_out; a.ws = (unsigned char*)d_ws; a.ph_lo = 0; a.ph_hi = NPHASES;
    void* args[] = {&a};
    hipError_t e = hipLaunchCooperativeKernel((const void*)fwd_megakernel, dim3(grid), dim3(NTHREADS), args, LDS_BYTES, stream);
    if (e != hipSuccess) fprintf(stderr, "kernel_launch: cooperative launch failed: %s (grid %d)\n", hipGetErrorString(e), grid);
}
```

```cpp
#include <hip/hip_runtime.h>
#include <hip/hip_cooperative_groups.h>
#include <cstdio>
#include <cstdint>
namespace cg = cooperative_groups;

#ifndef DBG_YMUL_A
#define DBG_YMUL_A 1.0f
#endif
#ifndef DBG_YMUL_B
#define DBG_YMUL_B 1.0f
#endif

#ifndef PROBE_REPEAT_KIND
#define PROBE_REPEAT_KIND (-1)
#endif
#ifndef PROBE_SCORE_REPS
#define PROBE_SCORE_REPS 1
#endif
#ifndef PROBE_SEL_REPS
#define PROBE_SEL_REPS 1
#endif
#ifndef PROBE_EXTRA_SYNCS
#define PROBE_EXTRA_SYNCS 0
#endif
#define LAS __attribute__((address_space(3)))
#define GAS __attribute__((address_space(1)))
typedef unsigned short bf16_t;
typedef short bf16x8 __attribute__((ext_vector_type(8)));
typedef float f32x4 __attribute__((ext_vector_type(4)));
typedef float f32x2 __attribute__((ext_vector_type(2)));
typedef float f32x16 __attribute__((ext_vector_type(16)));
typedef unsigned u32x4 __attribute__((ext_vector_type(4)));
typedef unsigned u32x2 __attribute__((ext_vector_type(2)));

constexpr int DM = 2048, NB = 16, SEQ = 2048, T = NB * SEQ, HD = 128, PLE = 256;
constexpr int AW = 6224;
constexpr int AWP = 6400;
constexpr int ANP = 5888;
constexpr float LN_EPS = 1e-5f;
constexpr float DN_ALPHA = 1.6817928305074290f;
constexpr float QSCALE = 0.08838834764831845f;
constexpr float LOG2E = 1.4426950408889634f;
constexpr int NWAVES = 8, NTHREADS = 512;

constexpr size_t MiB = 1u << 20;
constexpr size_t WS_WINA = 0;
constexpr size_t WS_WOUTA = 50 * MiB;
constexpr size_t WS_WQB = 66 * MiB;
constexpr size_t WS_WKV = 98 * MiB;
constexpr size_t WS_WOUTB = 114 * MiB;
constexpr size_t WS_WPLE = 130 * MiB;
constexpr size_t WS_WG = 134 * MiB;
constexpr size_t WS_XB1 = 166 * MiB;
constexpr size_t WS_XB2 = 294 * MiB;
constexpr size_t WS_QO = 422 * MiB;
constexpr size_t WS_SGP = 550 * MiB;
constexpr size_t WS_QI = 678 * MiB;
constexpr size_t WS_KA = 742 * MiB;
constexpr size_t WS_VTA = 774 * MiB;
constexpr size_t WS_KB = WS_QI;
constexpr size_t WS_KI = 806 * MiB;
constexpr size_t WS_WI = 810 * MiB;
constexpr size_t WS_MB = 812 * MiB;
constexpr size_t WS_VTB = 820 * MiB;
constexpr size_t WS_CS128 = 948 * MiB;
constexpr size_t WS_CS64 = 964 * MiB;
constexpr size_t WS_PBF = 972 * MiB;
constexpr size_t WS_BAR = 988 * MiB;
constexpr size_t WS_STATS = 988 * MiB + 65536;
constexpr size_t WS_LNP = WS_STATS + 1 * MiB;
constexpr size_t WS_GPART = WS_LNP + 131072;
constexpr size_t WS_END = 991 * MiB;

constexpr int LDS_BYTES = 147456, LDS_BARST = 131072 + 256;

__device__ const float ROPE_INV[64] = {
1.000000000e+00f, 8.659643531e-01f, 7.498942614e-01f, 6.493816376e-01f, 5.623413324e-01f, 4.869675338e-01f, 4.216965139e-01f, 3.651741147e-01f, 3.162277639e-01f, 2.738419771e-01f, 2.371373773e-01f, 2.053525001e-01f, 1.778279394e-01f, 1.539926529e-01f, 1.333521307e-01f, 1.154782027e-01f, 1.000000015e-01f, 8.659642935e-02f, 7.498941571e-02f, 6.493816525e-02f, 5.623413250e-02f, 4.869675264e-02f, 4.216965288e-02f, 3.651741147e-02f, 3.162277490e-02f, 2.738419734e-02f, 2.371373773e-02f, 2.053525113e-02f, 1.778279431e-02f, 1.539926510e-02f, 1.333521493e-02f, 1.154782064e-02f, 9.999999776e-03f, 8.659643121e-03f, 7.498941850e-03f, 6.493816152e-03f, 5.623413250e-03f, 4.869675264e-03f, 4.216964822e-03f, 3.651741194e-03f, 3.162277630e-03f, 2.738419687e-03f, 2.371373586e-03f, 2.053524833e-03f, 1.778279431e-03f, 1.539926510e-03f, 1.333521446e-03f, 1.154781901e-03f, 1.000000047e-03f, 8.659643354e-04f, 7.498942432e-04f, 6.493816618e-04f, 5.623413017e-04f, 4.869675322e-04f, 4.216965172e-04f, 3.651741426e-04f, 3.162277571e-04f, 2.738419571e-04f, 2.371373703e-04f, 2.053525095e-04f, 1.778279402e-04f, 1.539926452e-04f, 1.333521504e-04f, 1.154782003e-04f};

__device__ __forceinline__ unsigned cvt_pk_bf16(float lo, float hi) { unsigned r; asm volatile("v_cvt_pk_bf16_f32 %0, %1, %2" : "=v"(r) : "v"(lo), "v"(hi)); return r; }
__device__ __forceinline__ float bf_lo(unsigned w) { return __uint_as_float(w << 16); }
__device__ __forceinline__ float bf_hi(unsigned w) { return __uint_as_float(w & 0xffff0000u); }
__device__ __forceinline__ float fast_sigmoid(float a) { return __builtin_amdgcn_rcpf(1.0f + __builtin_amdgcn_exp2f(a * (-1.4426950408889634f))); }
__device__ __forceinline__ float xor32_sum(float v) { auto rr = __builtin_amdgcn_permlane32_swap(__float_as_uint(v), __float_as_uint(v), false, false); return __uint_as_float(rr[0]) + __uint_as_float(rr[1]); }
__device__ __forceinline__ float xor32_max(float v) { auto rr = __builtin_amdgcn_permlane32_swap(__float_as_uint(v), __float_as_uint(v), false, false); return fmaxf(__uint_as_float(rr[0]), __uint_as_float(rr[1])); }
__device__ __forceinline__ float xor32_get(float v, int hi) { auto rr = __builtin_amdgcn_permlane32_swap(__float_as_uint(v), __float_as_uint(v), false, false); return __uint_as_float(hi ? rr[0] : rr[1]); }
__device__ __forceinline__ int sbfe1(unsigned v, int bit) { int r; asm("v_bfe_i32 %0, %1, %2, 1" : "=v"(r) : "v"(v), "n"(bit)); return r; }
__device__ __forceinline__ float max3f(float a, float b, float c) { float r; asm("v_max3_f32 %0, %1, %2, %3" : "=v"(r) : "v"(a), "v"(b), "v"(c)); return r; }
__device__ __forceinline__ int crow(int r, int hi) { return (r & 3) + 8 * (r >> 2) + 4 * hi; }
__device__ __forceinline__ float wave_sum(float v, int lane) {
#pragma unroll
    for (int o = 1; o < 64; o <<= 1) v += __int_as_float(__builtin_amdgcn_ds_bpermute((lane ^ o) << 2, __float_as_int(v)));
    return v;
}


#define XB_TMO      128
#define XB_XCNT(j)  (256  + 64 * (j))
#define XB_XSUB(j)  (1280 + 64 * (j))
#define XB_XGEN(j)  (2304 + 64 * (j))
#define XB_TOP      3328
#define XB_TOPGEN   3392
#define XCD_BAR_WORDS 3456
#define XB_SPIN_CAP (1u << 22)
__device__ __forceinline__ unsigned xb_ld(unsigned* p)              { return __hip_atomic_load(p, __ATOMIC_RELAXED, __HIP_MEMORY_SCOPE_AGENT); }
__device__ __forceinline__ unsigned xb_add(unsigned* p, unsigned v) { return __hip_atomic_fetch_add(p, v, __ATOMIC_RELAXED, __HIP_MEMORY_SCOPE_AGENT); }
__device__ __forceinline__ unsigned xb_xcc_id() { return (unsigned)__builtin_amdgcn_s_getreg((3 << 11) | 20) & 0xFu; }
#define XB_SPIN(cond, bar) do { unsigned _sp = 0; while (cond) { __builtin_amdgcn_s_sleep(1); \
    if ((++_sp & 255u) == 0u) { if (xb_ld(&(bar)[XB_TMO])) break; if (_sp > XB_SPIN_CAP) { atomicAdd(&(bar)[XB_TMO], 1u); break; } } } } while (0)
__device__ __forceinline__ void xcd_barrier_complete(unsigned* bar, unsigned x, unsigned G, unsigned& nloc, unsigned& nx) {
    unsigned sum, cnt, mine, sp = 0u;
    for (;;) {
        sum = 0u; cnt = 0u; mine = 0u;
#pragma unroll
        for (unsigned j = 0; j < 16; ++j) { const unsigned c = xb_ld(&bar[XB_XCNT(j)]); sum += c; cnt += (c > 0u) ? 1u : 0u; mine = (j == x) ? c : mine; }
        if (sum == G) break;
        __builtin_amdgcn_s_sleep(1);
        if ((++sp & 255u) == 0u) { if (xb_ld(&bar[XB_TMO])) break; if (sp > XB_SPIN_CAP) { atomicAdd(&bar[XB_TMO], 1u); break; } }
    }
    nloc = mine > 0u ? mine : 1u; nx = cnt > 0u ? cnt : 1u;
}
__device__ __forceinline__ void xcd_barrier(unsigned* bar, volatile LAS unsigned* st, int tid, unsigned G) {
    asm volatile("s_waitcnt vmcnt(0)" ::: "memory");
    __syncthreads();
    if (tid == 0) {
        const unsigned x = xb_xcc_id();
        __builtin_amdgcn_s_waitcnt(0);
        unsigned nloc = st[0], nx = st[1];
        if (nloc == 0u) { xcd_barrier_complete(bar, x, G, nloc, nx); st[0] = nloc; st[1] = nx; }
        const unsigned old = xb_add(&bar[XB_XSUB(x)], 1u);
        const unsigned gen = old / nloc;
        if (old + 1u == (gen + 1u) * nloc) {
            __builtin_amdgcn_fence(__ATOMIC_RELEASE, "agent");
            asm volatile("s_waitcnt vmcnt(0)" ::: "memory");
            const unsigned og = xb_add(&bar[XB_TOP], 1u);
            const unsigned tg = og / nx;
            if (og + 1u == (tg + 1u) * nx) xb_add(&bar[XB_TOPGEN], 1u);
            else XB_SPIN(xb_ld(&bar[XB_TOPGEN]) == tg, bar);
            __builtin_amdgcn_fence(__ATOMIC_ACQUIRE, "agent");
            xb_add(&bar[XB_XGEN(x)], 1u);
            asm volatile("s_waitcnt vmcnt(0)" ::: "memory");
        } else {
            XB_SPIN(xb_ld(&bar[XB_XGEN(x)]) == gen, bar);
            __builtin_amdgcn_fence(__ATOMIC_ACQUIRE, "agent");
            asm volatile("s_waitcnt vmcnt(0)" ::: "memory");
        }
    }
    __syncthreads();
}

namespace pg8 {
constexpr int BM = 256, BK = 64, HALF = 128, HTB = HALF * BK * 2, STAGE_BYTES = 8 * HTB, NXCD = 8, WGM = 8;
__host__ __device__ __forceinline__ int lds_byte(int r, int c) { const int st = (r >> 4) * 2 + (c >> 5), rr = r & 15, cc = c & 31, ob = rr * 64 + cc * 2; return st * 1024 + (ob ^ (((ob >> 9) & 1) << 5)); }
__host__ __device__ __forceinline__ void stage_rc(int b, int& R, int& C) { const int st = b / 1024, sb = b % 1024, swz = sb ^ (((sb >> 9) & 1) << 5); R = (st >> 1) * 16 + swz / 64; C = (st & 1) * 32 + (swz % 64) / 2; }
__host__ __device__ __forceinline__ int perm32(int rho) { const int n = rho >> 4, i = rho & 15; return 8 * (i >> 2) + 4 * n + (i & 3); }
struct Unit { int pm, pn; };
struct Gemm { const bf16_t* A; const bf16_t* Bt; int M, N, K; };
struct StaticOrder {
    int nM, nN, nwg, G, c;
    __host__ __device__ void init(int M, int N, int G_, int c_) { nM = M / BM; nN = N / BM; nwg = nM * nN; G = G_; c = c_; }
    __host__ __device__ bool next(int i, Unit& u) const {
        const long L = (long)i * G + c; if (L >= nwg) return false;
        int wgid = (int)L; { const int q = nwg / NXCD, r = nwg % NXCD, xcd = wgid % NXCD, off = wgid / NXCD; wgid = (xcd < r ? xcd * (q + 1) : r * (q + 1) + (xcd - r) * q) + off; }
        const int nig = WGM * nN, gid = wgid / nig, fm = gid * WGM, gsz = (nM - fm) < WGM ? (nM - fm) : WGM;
        u.pm = fm + ((wgid % nig) % gsz); u.pn = (wgid % nig) / gsz; return true;
    }
};

enum { MODE_INA = 0, MODE_QG = 1, MODE_PLAIN = 2, MODE_OUT = 3, MODE_GATE = 4 };
struct Epi { int mode; unsigned char* ws; const float* xin; float* xf; bf16_t* O; int ldc; float ymul; int layer; };
template <int MODE_T> struct EpiT : Epi {
    __device__ __forceinline__ void operator()(const f32x4 (&acc)[2][2][4][2], const Unit& u, int wr, int wc, int fr, int fq) const {
        constexpr int mode = MODE_T;
        asm volatile("" : "+v"(fr), "+v"(fq));
        const int pn = u.pn;
        const int row0 = u.pm * BM + wr * 64 + fr;
        const int colw = wc * 32 + 8 * fq;
        if (mode == MODE_PLAIN) {
#pragma unroll
            for (int ai = 0; ai < 2; ++ai)
#pragma unroll
                for (int m = 0; m < 4; ++m) { bf16_t* rowp = O + (size_t)(row0 + ai * HALF + m * 16) * ldc + pn * BM + colw;
#pragma unroll
                    for (int bj = 0; bj < 2; ++bj) { const f32x4 v0 = acc[ai][bj][m][0], v1 = acc[ai][bj][m][1];
                        u32x4 w; w.x = cvt_pk_bf16(v0[0], v0[1]); w.y = cvt_pk_bf16(v0[2], v0[3]); w.z = cvt_pk_bf16(v1[0], v1[1]); w.w = cvt_pk_bf16(v1[2], v1[3]);
                        *(GAS u32x4*)(rowp + bj * HALF) = w; } }
        } else if (mode == MODE_OUT) {
            const GAS float* lnp = (const GAS float*)(ws + WS_LNP) + (size_t)layer * 4 * DM;
            GAS float* stats = (GAS float*)(ws + WS_STATS) + (size_t)layer * T * 2;
            bf16_t* zb = (bf16_t*)(ws + WS_QO); const bf16_t* xb2r = (const bf16_t*)(ws + WS_XB2);
            const int col0 = pn * BM + colw, lane = fr + 16 * fq;
            f32x4 gv[2][2];
#pragma unroll
            for (int bj = 0; bj < 2; ++bj)
#pragma unroll
                for (int n = 0; n < 2; ++n) gv[bj][n] = *(const GAS f32x4*)(lnp + col0 + bj * HALF + 4 * n);
#pragma unroll
            for (int ai = 0; ai < 2; ++ai) {
                u32x4 xwv[4][2];
#pragma unroll
                for (int i = 0; i < 4; ++i)
#pragma unroll
                    for (int bj = 0; bj < 2; ++bj) xwv[i][bj] = *(const GAS u32x4*)(xb2r + (size_t)(row0 + ai * HALF + i * 16) * DM + col0 + bj * HALF);
#pragma unroll
                for (int m = 0; m < 4; ++m) { const int row = row0 + ai * HALF + m * 16; const size_t off = (size_t)row * DM + col0;
                    float s1 = 0.f, s2 = 0.f;
#pragma unroll
                    for (int bj = 0; bj < 2; ++bj) { f32x4 z[2];
                        const u32x4 xw = xwv[m][bj];
#pragma unroll
                        for (int n = 0; n < 2; ++n) { const f32x4 xv = n == 0 ? (f32x4){bf_lo(xw.x), bf_hi(xw.x), bf_lo(xw.y), bf_hi(xw.y)} : (f32x4){bf_lo(xw.z), bf_hi(xw.z), bf_lo(xw.w), bf_hi(xw.w)};
                            z[n] = xv * DN_ALPHA + acc[ai][bj][m][n] * ymul;
                            s1 += (z[n][0] + z[n][1]) + (z[n][2] + z[n][3]); s2 += (z[n][0] * z[n][0] + z[n][1] * z[n][1]) + (z[n][2] * z[n][2] + z[n][3] * z[n][3]); }
                        const f32x4 y0 = z[0] * gv[bj][0], y1 = z[1] * gv[bj][1];
                        u32x4 w; w.x = cvt_pk_bf16(y0[0], y0[1]); w.y = cvt_pk_bf16(y0[2], y0[3]); w.z = cvt_pk_bf16(y1[0], y1[1]); w.w = cvt_pk_bf16(y1[2], y1[3]);
                        *(GAS u32x4*)(zb + off + bj * HALF) = w; }
                    s1 += __int_as_float(__builtin_amdgcn_ds_bpermute((lane ^ 16) << 2, __float_as_int(s1)));
                    s2 += __int_as_float(__builtin_amdgcn_ds_bpermute((lane ^ 16) << 2, __float_as_int(s2)));
                    s1 = xor32_sum(s1); s2 = xor32_sum(s2);
                    if (fq == 0) { __hip_atomic_fetch_add(stats + (size_t)row * 2, s1, __ATOMIC_RELAXED, __HIP_MEMORY_SCOPE_AGENT);
                                   __hip_atomic_fetch_add(stats + (size_t)row * 2 + 1, s2, __ATOMIC_RELAXED, __HIP_MEMORY_SCOPE_AGENT); } }
            }
        } else if (mode == MODE_GATE) {
            const GAS float* lnp = (const GAS float*)(ws + WS_LNP) + (size_t)layer * 4 * DM;
            const GAS float* stats = (const GAS float*)(ws + WS_STATS) + (size_t)layer * T * 2;
            const bf16_t* ple = (const bf16_t*)(ws + WS_SGP); bf16_t* xb2 = (bf16_t*)(ws + WS_XB2); const bf16_t* zb = (const bf16_t*)(ws + WS_QO);
#pragma unroll
            for (int bj = 0; bj < 2; ++bj) {
                const int c = pn * BM + bj * HALF + colw;
                const f32x4 g0 = *(const GAS f32x4*)(lnp + c), g1 = *(const GAS f32x4*)(lnp + c + 4), b0 = *(const GAS f32x4*)(lnp + DM + c), b1 = *(const GAS f32x4*)(lnp + DM + c + 4);
                const f32x4 gG0 = *(const GAS f32x4*)(lnp + 2 * DM + c), gG1 = *(const GAS f32x4*)(lnp + 2 * DM + c + 4);
                const f32x4 nbG0 = *(const GAS f32x4*)(lnp + 3 * DM + c) * (-LOG2E), nbG1 = *(const GAS f32x4*)(lnp + 3 * DM + c + 4) * (-LOG2E);
                u32x4 zw_n = *(const GAS u32x4*)(zb + (size_t)row0 * DM + c), pw_n = *(const GAS u32x4*)(ple + (size_t)row0 * DM + c);
                f32x2 st_n = *(const GAS f32x2*)(stats + (size_t)row0 * 2);
#pragma unroll
                for (int ai = 0; ai < 2; ++ai) {
#pragma unroll
                    for (int m = 0; m < 4; ++m) { const int row = row0 + ai * HALF + m * 16; const size_t off = (size_t)row * DM + c;
                        const u32x4 zw = zw_n, pw = pw_n; const f32x2 st = st_n;
                        if (ai * 4 + m < 7) { const int rown = row0 + ((ai * 4 + m + 1) >> 2) * HALF + ((ai * 4 + m + 1) & 3) * 16; const size_t offn = (size_t)rown * DM + c;
                            zw_n = *(const GAS u32x4*)(zb + offn); pw_n = *(const GAS u32x4*)(ple + offn); st_n = *(const GAS f32x2*)(stats + (size_t)rown * 2); }
                        asm volatile("" :: "v"(zw), "v"(pw), "v"(st));
                        const float mean = st.x * (1.0f / DM), var = st.y * (1.0f / DM) - mean * mean, rstd = __builtin_amdgcn_rsqf(var + LN_EPS);
                        const float Bc = -mean * rstd, An = -rstd * LOG2E, Bn = mean * rstd * LOG2E;
                        const f32x4 zg0 = (f32x4){bf_lo(zw.x), bf_hi(zw.x), bf_lo(zw.y), bf_hi(zw.y)}, zg1 = (f32x4){bf_lo(zw.z), bf_hi(zw.z), bf_lo(zw.w), bf_hi(zw.w)};
                        const f32x4 x0 = zg0 * rstd + (g0 * Bc + b0), x1 = zg1 * rstd + (g1 * Bc + b1);
                        const f32x4 t0 = acc[ai][bj][m][0] * An + (gG0 * Bn + nbG0), t1 = acc[ai][bj][m][1] * An + (gG1 * Bn + nbG1);
                        f32x4 o0, o1;
#define SIGX(t) __builtin_amdgcn_rcpf(1.0f + __builtin_amdgcn_exp2f(t))
                        o0[0] = x0[0] + bf_lo(pw.x) * SIGX(t0[0]); o0[1] = x0[1] + bf_hi(pw.x) * SIGX(t0[1]);
                        o0[2] = x0[2] + bf_lo(pw.y) * SIGX(t0[2]); o0[3] = x0[3] + bf_hi(pw.y) * SIGX(t0[3]);
                        o1[0] = x1[0] + bf_lo(pw.z) * SIGX(t1[0]); o1[1] = x1[1] + bf_hi(pw.z) * SIGX(t1[1]);
                        o1[2] = x1[2] + bf_lo(pw.w) * SIGX(t1[2]); o1[3] = x1[3] + bf_hi(pw.w) * SIGX(t1[3]);
#undef SIGX
                        if (layer == 3) { *(GAS f32x4*)(xf + off) = o0; *(GAS f32x4*)(xf + off + 4) = o1; }
                        u32x4 w; w.x = cvt_pk_bf16(o0[0], o0[1]); w.y = cvt_pk_bf16(o0[2], o0[3]); w.z = cvt_pk_bf16(o1[0], o1[1]); w.w = cvt_pk_bf16(o1[2], o1[3]);
                        *(GAS u32x4*)(xb2 + off) = w; }
                }
            }
        } else if (mode == MODE_QG) {
            const bool isq = pn < 8;
            bf16_t* base = isq ? (bf16_t*)(ws + WS_QO) + pn * BM : (bf16_t*)(ws + WS_SGP) + (pn - 8) * BM;
#pragma unroll
            for (int ai = 0; ai < 2; ++ai)
#pragma unroll
                for (int m = 0; m < 4; ++m) { bf16_t* rowp = base + (size_t)(row0 + ai * HALF + m * 16) * DM + colw;
#pragma unroll
                    for (int bj = 0; bj < 2; ++bj) { f32x4 v0 = acc[ai][bj][m][0], v1 = acc[ai][bj][m][1];
                        if (isq) { v0 = v0 * (QSCALE * LOG2E); v1 = v1 * (QSCALE * LOG2E); }
                        else {
#pragma unroll
                            for (int j = 0; j < 4; ++j) { v0[j] = v0[j] * fast_sigmoid(v0[j]); v1[j] = v1[j] * fast_sigmoid(v1[j]); } }
                        u32x4 w; w.x = cvt_pk_bf16(v0[0], v0[1]); w.y = cvt_pk_bf16(v0[2], v0[3]); w.z = cvt_pk_bf16(v1[0], v1[1]); w.w = cvt_pk_bf16(v1[2], v1[3]);
                        *(GAS u32x4*)(rowp + bj * HALF) = w; } }
        } else {
            const GAS f32x4* cs128 = (const GAS f32x4*)(ws + WS_CS128); const GAS f32x4* cs64 = (const GAS f32x4*)(ws + WS_CS64);
#pragma unroll
            for (int ai = 0; ai < 2; ++ai)
#pragma unroll
                for (int m = 0; m < 4; ++m) {
                    const int row = row0 + ai * HALF + m * 16;
                    if (pn < 10) {
                        const f32x4 c0 = cs128[(size_t)row * 32 + wc * 8 + fq * 2], c1 = cs128[(size_t)row * 32 + wc * 8 + fq * 2 + 1];
                        const float sc = pn < 8 ? QSCALE * LOG2E : 1.0f;
                        bf16_t* rowp = (pn < 8 ? (bf16_t*)(ws + WS_QO) + (size_t)row * DM + pn * BM : (bf16_t*)(ws + WS_KA) + (size_t)row * 512 + (pn - 8) * BM) + colw;
#pragma unroll
                        for (int bj = 0; bj < 2; ++bj) { const f32x4 v0 = acc[ai][bj][m][0] * sc, v1 = acc[ai][bj][m][1] * sc;
                            u32x4 w;
                            w.x = cvt_pk_bf16(v0[0] * c0[0] - v0[1] * c0[1], v0[1] * c0[0] + v0[0] * c0[1]);
                            w.y = cvt_pk_bf16(v0[2] * c0[2] - v0[3] * c0[3], v0[3] * c0[2] + v0[2] * c0[3]);
                            w.z = cvt_pk_bf16(v1[0] * c1[0] - v1[1] * c1[1], v1[1] * c1[0] + v1[0] * c1[1]);
                            w.w = cvt_pk_bf16(v1[2] * c1[2] - v1[3] * c1[3], v1[3] * c1[2] + v1[2] * c1[3]);
                            *(GAS u32x4*)(rowp + bj * HALF) = w; }
                    } else if (pn < 18) {
                        bf16_t* rowp = (bf16_t*)(ws + WS_SGP) + (size_t)row * DM + (pn - 10) * BM + colw;
#pragma unroll
                        for (int bj = 0; bj < 2; ++bj) { f32x4 v0 = acc[ai][bj][m][0], v1 = acc[ai][bj][m][1];
#pragma unroll
                            for (int j = 0; j < 4; ++j) { v0[j] = v0[j] * fast_sigmoid(v0[j]); v1[j] = v1[j] * fast_sigmoid(v1[j]); }
                            u32x4 w; w.x = cvt_pk_bf16(v0[0], v0[1]); w.y = cvt_pk_bf16(v0[2], v0[3]); w.z = cvt_pk_bf16(v1[0], v1[1]); w.w = cvt_pk_bf16(v1[2], v1[3]);
                            *(GAS u32x4*)(rowp + bj * HALF) = w; }
                    } else {
                        const f32x4 c0 = cs64[(size_t)row * 16 + (wc & 1) * 8 + fq * 2], c1 = cs64[(size_t)row * 16 + (wc & 1) * 8 + fq * 2 + 1];
#pragma unroll
                        for (int bj = 0; bj < 2; ++bj) { const f32x4 v0 = acc[ai][bj][m][0], v1 = acc[ai][bj][m][1];
                            u32x4 w;
                            w.x = cvt_pk_bf16(v0[0] * c0[0] - v0[1] * c0[1], v0[1] * c0[0] + v0[0] * c0[1]);
                            w.y = cvt_pk_bf16(v0[2] * c0[2] - v0[3] * c0[3], v0[3] * c0[2] + v0[2] * c0[3]);
                            w.z = cvt_pk_bf16(v1[0] * c1[0] - v1[1] * c1[1], v1[1] * c1[0] + v1[0] * c1[1]);
                            w.w = cvt_pk_bf16(v1[2] * c1[2] - v1[3] * c1[3], v1[3] * c1[2] + v1[2] * c1[3]);
                            if (pn < 22) { *(GAS u32x4*)((bf16_t*)(ws + WS_QI) + (size_t)row * 1024 + (pn - 18) * BM + bj * HALF + colw) = w; }
                            else if (bj == 0) {
                                if (wc < 2) *(GAS u32x4*)((bf16_t*)(ws + WS_KI) + (size_t)row * 64 + colw) = w;
                                else if (wc == 2 && fq < 2) { float* wp = (float*)(ws + WS_WI) + (size_t)row * 16 + 8 * fq;
                                    *(GAS f32x4*)(wp) = v0 * 0.03125f; *(GAS f32x4*)(wp + 4) = v1 * 0.03125f; }
                            } }
                    }
                }
        }
    }
};

template <class EpiT, class Sched>
__device__ __forceinline__ void gemm_phase(LAS unsigned char* lds, const Gemm g, const Sched& S, const EpiT& E, const int wid) {
    constexpr bool ALIGN_EPI = true;
    int lane; asm volatile("v_mbcnt_lo_u32_b32 %0, -1, 0\n\tv_mbcnt_hi_u32_b32 %0, -1, %0" : "=v"(lane));
    const int tid = wid * 64 + lane, wr = wid >> 2, wc = wid & 3, fr = lane & 15, fq = lane >> 4;
    const int K = g.K, nt = K / BK;
    unsigned voffA[2], voffB[2];
#pragma unroll
    for (int i = 0; i < 2; ++i) { int R, C; stage_rc(tid * 16 + i * 8192, R, C); const int Rb = (R & ~31) + perm32(R & 31);
        voffA[i] = (unsigned)(R * K + C) * 2u; voffB[i] = (unsigned)(Rb * K + C) * 2u; }
    const size_t kstep = (size_t)(BK * 2);
    const size_t hstep = (size_t)HALF * K * 2;
    const size_t tstep = 2 * hstep;
    const unsigned ldsw = (unsigned)wid * 1024u;
    const int aoff = lds_byte(wr * 64 + fr, fq * 8), boff = lds_byte(wc * 32 + fr, fq * 8);
#define PG8_SA(b, h) (((b) * 2 + (h)) * HTB)
#define PG8_SB(b, h) ((4 + (b) * 2 + (h)) * HTB)
#define PG8_STAGE(bufoff, gbase, voff) do { _Pragma("unroll") for (int _i = 0; _i < 2; ++_i) \
        __builtin_amdgcn_global_load_lds((const unsigned*)((const char*)(gbase) + (voff)[_i]), (LAS unsigned*)(lds + (bufoff) + ldsw + _i * 8192), 16, 0, 0); } while (0)
#define PG8_LDA(dst, b, h) do { _Pragma("unroll") for (int m = 0; m < 4; ++m) _Pragma("unroll") for (int k = 0; k < 2; ++k) dst[m][k] = *(const LAS bf16x8*)(lds + PG8_SA(b, h) + aoff + m * 2048 + k * 1024); } while (0)
#define PG8_LDB(dst, b, h) do { _Pragma("unroll") for (int n = 0; n < 2; ++n) _Pragma("unroll") for (int k = 0; k < 2; ++k) dst[n][k] = *(const LAS bf16x8*)(lds + PG8_SB(b, h) + boff + n * 2048 + k * 1024); } while (0)
#define PG8_MMA(ai, bj, At, Bt) do { __builtin_amdgcn_s_setprio(1); _Pragma("unroll") for (int m = 0; m < 4; ++m) _Pragma("unroll") for (int n = 0; n < 2; ++n) _Pragma("unroll") for (int k = 0; k < 2; ++k) \
        acc[ai][bj][m][n] = __builtin_amdgcn_mfma_f32_16x16x32_bf16(Bt[n][k], At[m][k], acc[ai][bj][m][n], 0, 0, 0); __builtin_amdgcn_s_setprio(0); } while (0)
#define PG8_WAIT_V(n) asm volatile("s_waitcnt vmcnt(" #n ")" ::: "memory")
#define PG8_WAIT_L(n) asm volatile("s_waitcnt lgkmcnt(" #n ")" ::: "memory")
#define PG8_BAR __builtin_amdgcn_s_barrier()
#define PG8_SCHED __builtin_amdgcn_sched_barrier(0)
    Unit cur, nxt; int ui = 0;
    if (!S.next(0, cur)) return;
    f32x4 acc[2][2][4][2];
#pragma unroll
    for (int a = 0; a < 2; ++a)
#pragma unroll
        for (int b = 0; b < 2; ++b)
#pragma unroll
            for (int m = 0; m < 4; ++m)
#pragma unroll
                for (int n = 0; n < 2; ++n) acc[a][b][m][n] = (f32x4){0.f, 0.f, 0.f, 0.f};
    bf16x8 At[4][2], B0[2][2], B1[2][2];
    const char* cA = (const char*)g.A + (size_t)cur.pm * tstep; const char* cB = (const char*)g.Bt + (size_t)cur.pn * tstep;
    PG8_STAGE(PG8_SB(0, 0), cB, voffB); PG8_STAGE(PG8_SB(0, 1), cB + hstep, voffB); PG8_STAGE(PG8_SA(0, 0), cA, voffA); PG8_STAGE(PG8_SA(0, 1), cA + hstep, voffA);
    if (wr == 1) PG8_BAR;
    PG8_WAIT_V(2); PG8_BAR;
    PG8_STAGE(PG8_SB(1, 0), cB + kstep, voffB); PG8_STAGE(PG8_SA(1, 0), cA + kstep, voffA); PG8_STAGE(PG8_SB(1, 1), cB + hstep + kstep, voffB);
    PG8_WAIT_V(6); PG8_BAR;
    for (;;) {
        const bool has_next = S.next(ui + 1, nxt);
        const char* nA = has_next ? (const char*)g.A + (size_t)nxt.pm * tstep : cA; const char* nB = has_next ? (const char*)g.Bt + (size_t)nxt.pn * tstep : cB;
        for (int t = 0; t < nt; t += 2) {
            const bool last = (t == nt - 2);
            const char* a1 = cA + (size_t)(t + 1) * kstep;
            const char* a2 = last ? nA : cA + (size_t)(t + 2) * kstep; const char* b2 = last ? nB : cB + (size_t)(t + 2) * kstep;
            const char* a3 = a2 + kstep; const char* b3 = b2 + kstep;
            PG8_LDB(B0, 0, 0); PG8_LDB(B1, 0, 1); PG8_SCHED; PG8_LDA(At, 0, 0); PG8_STAGE(PG8_SA(1, 1), a1 + hstep, voffA);
            PG8_WAIT_V(8); PG8_WAIT_L(0); PG8_BAR; PG8_MMA(0, 0, At, B0); PG8_MMA(0, 1, At, B1); PG8_BAR; PG8_SCHED;
            PG8_LDA(At, 0, 1); PG8_STAGE(PG8_SB(0, 0), b2, voffB); PG8_STAGE(PG8_SB(0, 1), b2 + hstep, voffB); PG8_STAGE(PG8_SA(0, 0), a2, voffA);
            PG8_WAIT_V(8); PG8_WAIT_L(0); PG8_BAR; PG8_MMA(1, 0, At, B0); PG8_MMA(1, 1, At, B1); PG8_BAR; PG8_SCHED;
            PG8_LDB(B0, 1, 0); PG8_LDB(B1, 1, 1); PG8_SCHED; PG8_LDA(At, 1, 0); PG8_STAGE(PG8_SA(0, 1), a2 + hstep, voffA);
            PG8_WAIT_V(8); PG8_WAIT_L(0); PG8_BAR; PG8_MMA(0, 0, At, B0); PG8_MMA(0, 1, At, B1); PG8_BAR; PG8_SCHED;
            PG8_LDA(At, 1, 1); PG8_STAGE(PG8_SB(1, 0), b3, voffB); PG8_STAGE(PG8_SB(1, 1), b3 + hstep, voffB); PG8_STAGE(PG8_SA(1, 0), a3, voffA);
            PG8_WAIT_V(8); PG8_WAIT_L(0); PG8_BAR; PG8_MMA(1, 0, At, B0); PG8_MMA(1, 1, At, B1); PG8_BAR; PG8_SCHED;
        }
        if constexpr (ALIGN_EPI) { if (wr == 0) PG8_BAR; }
        E(acc, cur, wr, wc, fr, fq);
        if (!has_next) break;
#pragma unroll
        for (int a = 0; a < 2; ++a)
#pragma unroll
            for (int b = 0; b < 2; ++b)
#pragma unroll
                for (int m = 0; m < 4; ++m)
#pragma unroll
                    for (int n = 0; n < 2; ++n) acc[a][b][m][n] = (f32x4){0.f, 0.f, 0.f, 0.f};
        cur = nxt; cA = nA; cB = nB; ++ui;
        if constexpr (ALIGN_EPI) { if (wr == 1) PG8_BAR; }
    }
    PG8_WAIT_V(0);
    if constexpr (!ALIGN_EPI) { if (wr == 0) PG8_BAR; }
    PG8_BAR;
#undef PG8_SA
#undef PG8_SB
#undef PG8_STAGE
#undef PG8_LDA
#undef PG8_LDB
#undef PG8_MMA
#undef PG8_WAIT_V
#undef PG8_WAIT_L
#undef PG8_BAR
#undef PG8_SCHED
}
}

struct Args {
    const float* x; const float* p; const int* pos; const float* w_in_a; const float* w_out_a; const float* w_q_b; const float* w_kv_b; const float* w_out_b;
    const float* ln_g; const float* ln_b; const float* w_ple; const float* w_ple_gate; float* out; unsigned char* ws; int ph_lo, ph_hi;
};

__device__ __forceinline__ int mapA(int n) {
    if (n < 2560) { const int head = n >> 7, w = n & 127; return head * 128 + (w >> 1) + 64 * (w & 1); }
    if (n < 4608) return 3072 + (n - 2560);
    if (n < 5632) { const int c = n - 4608, head = c >> 6, w = c & 63; return 5120 + head * 64 + (w >> 1) + 32 * (w & 1); }
    if (n < 5696) { const int w = n - 5632; return 6160 + (w >> 1) + 32 * (w & 1); }
    if (n < 5712) return 6144 + (n - 5696);
    if (n < 5888) return -1;
    return 2560 + (n - 5888);
}
template <bool MAPA>
__device__ __forceinline__ void transpose_item(const float* W, int K, int N, int NP, bf16_t* WT, LAS float* scr, int item, int lane) {
    const int nblk = NP / 32, kb = item / nblk, nb = item % nblk, k0 = 64 * kb, n0 = 32 * nb;
    const int nphys = n0 + (lane & 31);
    const int src = MAPA ? mapA(nphys) : nphys;
#pragma unroll
    for (int i = 0; i < 32; ++i) { const int kk = 2 * i + (lane >> 5); scr[kk * 33 + (lane & 31)] = src >= 0 ? ((const GAS float*)W)[(size_t)(k0 + kk) * N + src] : 0.f; }
    asm volatile("s_waitcnt lgkmcnt(0)" ::: "memory");
    const int c = lane & 7;
#pragma unroll
    for (int j = 0; j < 4; ++j) { const int n = (lane >> 3) + 8 * j; const LAS float* s = scr + (8 * c) * 33 + n;
        u32x4 o; o.x = cvt_pk_bf16(s[0 * 33], s[1 * 33]); o.y = cvt_pk_bf16(s[2 * 33], s[3 * 33]); o.z = cvt_pk_bf16(s[4 * 33], s[5 * 33]); o.w = cvt_pk_bf16(s[6 * 33], s[7 * 33]);
        *(GAS u32x4*)(WT + (size_t)(n0 + n) * K + k0 + 8 * c) = o; }
    asm volatile("s_waitcnt lgkmcnt(0)" ::: "memory");
}
__device__ __forceinline__ void cvt_rows(const float* src, bf16_t* dst, size_t n8, size_t gtid, size_t gthreads) {
    size_t i = gtid;
    for (; i + 3 * gthreads < n8; i += 4 * gthreads) {
        f32x4 a[4], b[4];
#pragma unroll
        for (int j = 0; j < 4; ++j) { a[j] = *(const GAS f32x4*)(src + (i + j * gthreads) * 8); b[j] = *(const GAS f32x4*)(src + (i + j * gthreads) * 8 + 4); }
#pragma unroll
        for (int j = 0; j < 4; ++j) { u32x4 w; w.x = cvt_pk_bf16(a[j][0], a[j][1]); w.y = cvt_pk_bf16(a[j][2], a[j][3]); w.z = cvt_pk_bf16(b[j][0], b[j][1]); w.w = cvt_pk_bf16(b[j][2], b[j][3]);
            *(GAS u32x4*)(dst + (i + j * gthreads) * 8) = w; }
    }
    for (; i < n8; i += gthreads) { const f32x4 a = *(const GAS f32x4*)(src + i * 8), b = *(const GAS f32x4*)(src + i * 8 + 4);
        u32x4 w; w.x = cvt_pk_bf16(a[0], a[1]); w.y = cvt_pk_bf16(a[2], a[3]); w.z = cvt_pk_bf16(b[0], b[1]); w.w = cvt_pk_bf16(b[2], b[3]);
        *(GAS u32x4*)(dst + i * 8) = w; }
}
__device__ __forceinline__ void prologue(const Args& a, LAS unsigned char* lds, int bx, int G, int tid, int wave, int lane) {
    LAS float* scr = (LAS float*)(lds + wave * 16384);
    const int gw = bx * NWAVES + wave, NGW = G * NWAVES;
    unsigned char* ws = a.ws;
    constexpr int I_INA = (DM / 64) * (AWP / 32);
    constexpr int I_SQ = (DM / 64) * (DM / 32);
    constexpr int I_W4 = (DM / 64) * (4096 / 32);
    constexpr int I_PLE = (PLE / 64) * (DM / 32);
    constexpr int NITEMS = 2 * I_INA + 2 * I_SQ + 2 * I_W4 + I_W4 + 2 * I_SQ + 4 * I_PLE + 4 * I_SQ;
    for (int it = gw; it < NITEMS; it += NGW) {
        int r = it;
        if (r < 2 * I_INA) { const int l = r / I_INA; transpose_item<true>(a.w_in_a + (size_t)l * DM * AW, DM, AW, AWP, (bf16_t*)(ws + WS_WINA) + (size_t)l * AWP * DM, scr, r % I_INA, lane); continue; } r -= 2 * I_INA;
        if (r < 2 * I_SQ) { const int l = r / I_SQ; transpose_item<false>(a.w_out_a + (size_t)l * DM * DM, DM, DM, DM, (bf16_t*)(ws + WS_WOUTA) + (size_t)l * DM * DM, scr, r % I_SQ, lane); continue; } r -= 2 * I_SQ;
        if (r < 2 * I_W4) { const int l = r / I_W4; transpose_item<false>(a.w_q_b + (size_t)l * DM * 4096, DM, 4096, 4096, (bf16_t*)(ws + WS_WQB) + (size_t)l * 4096 * DM, scr, r % I_W4, lane); continue; } r -= 2 * I_W4;
        if (r < I_W4) { transpose_item<false>(a.w_kv_b, DM, 4096, 4096, (bf16_t*)(ws + WS_WKV), scr, r, lane); continue; } r -= I_W4;
        if (r < 2 * I_SQ) { const int l = r / I_SQ; transpose_item<false>(a.w_out_b + (size_t)l * DM * DM, DM, DM, DM, (bf16_t*)(ws + WS_WOUTB) + (size_t)l * DM * DM, scr, r % I_SQ, lane); continue; } r -= 2 * I_SQ;
        if (r < 4 * I_PLE) { const int l = r / I_PLE; transpose_item<false>(a.w_ple + (size_t)l * PLE * DM, PLE, DM, DM, (bf16_t*)(ws + WS_WPLE) + (size_t)l * DM * PLE, scr, r % I_PLE, lane); continue; } r -= 4 * I_PLE;
        { const int l = r / I_SQ; transpose_item<false>(a.w_ple_gate + (size_t)l * DM * DM, DM, DM, DM, (bf16_t*)(ws + WS_WG) + (size_t)l * DM * DM, scr, r % I_SQ, lane); }
    }
    if (bx == 0) { unsigned* bar = (unsigned*)(ws + WS_BAR); for (int i = tid; i < XCD_BAR_WORDS; i += NTHREADS) __hip_atomic_store(bar + i, 0u, __ATOMIC_RELAXED, __HIP_MEMORY_SCOPE_AGENT); }
    const size_t gtid = (size_t)bx * NTHREADS + tid, gthreads = (size_t)G * NTHREADS;
    cvt_rows(a.x, (bf16_t*)(ws + WS_XB2), (size_t)T * DM / 8, gtid, gthreads);
    cvt_rows(a.p, (bf16_t*)(ws + WS_PBF), (size_t)T * PLE / 8, gtid, gthreads);
    { GAS f32x4* st = (GAS f32x4*)(ws + WS_STATS); f32x4 zz = (f32x4){0.f, 0.f, 0.f, 0.f}; asm volatile("" : "+v"(zz)); for (size_t i = gtid; i < (size_t)4 * T * 2 / 4; i += gthreads) st[i] = zz;
      GAS float* lnp = (GAS float*)(ws + WS_LNP);
      for (size_t i = gtid; i < (size_t)4 * DM; i += gthreads) { const int l = (int)(i >> 11), c = (int)(i & 2047); lnp[(size_t)l * 4 * DM + c] = ((const GAS float*)a.ln_g)[i]; lnp[(size_t)l * 4 * DM + DM + c] = ((const GAS float*)a.ln_b)[i]; }
      GAS float* gp = (GAS float*)(ws + WS_GPART);
      for (size_t i = gtid; i < (size_t)16 * 4 * DM; i += gthreads) { const int c = (int)(i & 2047), l = (int)(i >> 11) & 3, ks = (int)(i >> 13);
          const GAS float* Gm = (const GAS float*)a.w_ple_gate + (size_t)l * DM * DM + (size_t)(ks * 128) * DM + c;
          const GAS float* gk = (const GAS float*)a.ln_g + l * DM + ks * 128; const GAS float* bk = (const GAS float*)a.ln_b + l * DM + ks * 128;
          float pg = 0.f, pb = 0.f;
#pragma unroll 8
          for (int k = 0; k < 128; ++k) { const float Gv = Gm[(size_t)k * DM]; pg += gk[k] * Gv; pb += bk[k] * Gv; }
          gp[((size_t)(ks * 4 + l) * 2 + 0) * DM + c] = pg; gp[((size_t)(ks * 4 + l) * 2 + 1) * DM + c] = pb; } }
    GAS f32x2* cs128 = (GAS f32x2*)(ws + WS_CS128); GAS f32x2* cs64 = (GAS f32x2*)(ws + WS_CS64);
    for (size_t i = gtid; i < (size_t)T * 64; i += gthreads) {
        const int tok = (int)(i >> 6), f = (int)(i & 63);
        const float ang = (float)((const GAS int*)a.pos)[tok] * ROPE_INV[f];
        const float n = rintf(ang * 0.15915494309189535f);
        float r = fmaf(-n, 6.2831854820251465f, ang); r = fmaf(-n, -1.7484555e-7f, r);
        const float c = __cosf(r), s = __sinf(r);
        cs128[i] = (f32x2){c, s};
        if ((f & 1) == 0) cs64[(size_t)tok * 32 + (f >> 1)] = (f32x2){c, s};
    }
}

__device__ __forceinline__ float relu_i(float x) { const int b = __float_as_int(x); return __int_as_float(b > 0 ? b : 0); }
__device__ __forceinline__ unsigned sortable(float f) { const unsigned u = __float_as_uint(f); return (u & 0x80000000u) ? ~u : (u | 0x80000000u); }
__device__ __forceinline__ void indexer_unit(const Args& a, LAS unsigned char* lds, int b, int t0, int wave, int lane) {
    const bf16_t* QI = (const bf16_t*)(a.ws + WS_QI); const bf16_t* KI = (const bf16_t*)(a.ws + WS_KI); const float* WI = (const float*)(a.ws + WS_WI);
    unsigned long long* MB = (unsigned long long*)(a.ws + WS_MB);
    const int l31 = lane & 31, hi = lane >> 5;
    const int tA = t0 + 2 * wave;
    const bf16_t* qrow = QI + (size_t)(b * SEQ + tA + (l31 >> 4)) * 1024 + (l31 & 15) * 64;
    bf16x8 qa[4];
#pragma unroll
    for (int kk = 0; kk < 4; ++kk) qa[kk] = *(const GAS bf16x8*)(qrow + kk * 16 + hi * 8);
    float w[16];
#pragma unroll
    for (int r = 0; r < 16; ++r) w[r] = ((const GAS float*)WI)[(size_t)(b * SEQ + tA + (r >> 3)) * 16 + (r & 3) + 8 * ((r >> 2) & 1) + 4 * hi];
    LAS float* sc = (LAS float*)lds + wave * 4096;
    const int npair = ((t0 + 15) / 32 + 2) / 2;
    const bf16_t* kbase = KI + (size_t)(b * SEQ + l31) * 64 + hi * 8;
    bf16x8 kA[8], kB[8], kC[8];
#define IDX_LOAD(dst, pr_) do { const int prc_ = (pr_) < npair ? (pr_) : npair - 1; _Pragma("unroll") for (int i = 0; i < 8; ++i) \
        dst[i] = *(const GAS bf16x8*)(kbase + (size_t)(prc_ * 64 + (i >> 2) * 32) * 64 + (i & 3) * 16); } while (0)
#define IDX_SCORE(kc, pr_) do { f32x16 acc0 = {}, acc1 = {}; \
        _Pragma("unroll") for (int kk = 0; kk < 4; ++kk) { acc0 = __builtin_amdgcn_mfma_f32_32x32x16_bf16(qa[kk], kc[kk], acc0, 0, 0, 0); acc1 = __builtin_amdgcn_mfma_f32_32x32x16_bf16(qa[kk], kc[4 + kk], acc1, 0, 0, 0); } \
        float s0 = 0.f, s1 = 0.f, s2 = 0.f, s3 = 0.f; \
        _Pragma("unroll") for (int r = 0; r < 8; ++r) { s0 += w[r] * relu_i(acc0[r]); s1 += w[r + 8] * relu_i(acc0[r + 8]); s2 += w[r] * relu_i(acc1[r]); s3 += w[r + 8] * relu_i(acc1[r + 8]); } \
        s0 = xor32_sum(s0); s1 = xor32_sum(s1); s2 = xor32_sum(s2); s3 = xor32_sum(s3); \
        if (hi == 0) { sc[(pr_) * 64 + l31] = s0; sc[(pr_) * 64 + 32 + l31] = s2; } else { sc[2048 + (pr_) * 64 + l31] = s1; sc[2048 + (pr_) * 64 + 32 + l31] = s3; } } while (0)
#pragma unroll
    for (int kk = 0; kk < 4; ++kk) asm volatile("" :: "v"(qa[kk]));
#pragma unroll
    for (int r = 0; r < 16; ++r) asm volatile("" :: "v"(w[r]));
    IDX_LOAD(kA, 0); IDX_LOAD(kB, 1);
    for (int pr = 0; pr < npair; pr += 3) {
        IDX_LOAD(kC, pr + 2);
        IDX_SCORE(kA, pr);
        IDX_LOAD(kA, pr + 3);
        if (pr + 1 < npair) IDX_SCORE(kB, pr + 1);
        IDX_LOAD(kB, pr + 4);
        if (pr + 2 < npair) IDX_SCORE(kC, pr + 2);
    }
#undef IDX_LOAD
#undef IDX_SCORE
    const int tB = tA + 1;
    unsigned uA[32], uB[32];
#pragma unroll
    for (int i = 0; i < 32; ++i) { const int key = lane + 64 * i; const unsigned xa = sortable(sc[key]), xb = sortable(sc[2048 + key]); uA[i] = key <= tA ? xa : 0u; uB[i] = key <= tB ? xb : 0u; }
    const int ng = (tB >> 9) + 1;
    unsigned thrA = 1u, thrB = 1u;
    for (int prb = 0; prb < PROBE_SEL_REPS; ++prb) {
    asm volatile("" : "+s"(thrA), "+s"(thrB));
    if (tB + 1 > 256) {
        thrA = 0u; thrB = 0u;
#pragma unroll 1
        for (int bit = 31; bit >= 0; --bit) {
            const unsigned candA = thrA | (1u << bit), candB = thrB | (1u << bit);
            int cntA = 0, cntB = 0;
#pragma unroll
            for (int g = 0; g < 4; ++g) if (g < ng) {
#pragma unroll
                for (int i = 8 * g; i < 8 * g + 8; ++i) { cntA += __builtin_popcountll(__ballot(uA[i] >= candA)); cntB += __builtin_popcountll(__ballot(uB[i] >= candB)); }
            }
            if (cntA >= 256) thrA = candA;
            if (cntB >= 256) thrB = candB;
        }
        if (tA + 1 <= 256) thrA = 1u;
        if (thrA == 0u) thrA = 1u;
        if (thrB == 0u) thrB = 1u;
    }
    }
    unsigned long long mineA = 0ull, mineB = 0ull;
#pragma unroll
    for (int i = 0; i < 32; ++i) { const unsigned long long ba = __ballot(uA[i] >= thrA), bb = __ballot(uB[i] >= thrB); if (lane == i) { mineA = ba; mineB = bb; } }
    if (lane < 32) { ((GAS unsigned long long*)MB)[(size_t)(b * SEQ + tA) * 32 + lane] = mineA; ((GAS unsigned long long*)MB)[(size_t)(b * SEQ + tB) * 32 + lane] = mineB; }
}
__device__ __forceinline__ void indexer_phase(const Args& a, LAS unsigned char* lds, int bx, int G, int wave, int lane) {
    for (int L = bx; L < 2048; L += G) {
        const int i = L >> 8, c = L & 255;
        const int b = (c >> 7) + 2 * i;
        const int tb = (i & 1) ? 127 - (c & 127) : (c & 127);
        indexer_unit(a, lds, b, tb * 16, wave, lane);
    }
}

constexpr int KPITCH = 272, VPITCH = 144, KTILE_B = 64 * KPITCH, VTILE_B = 128 * VPITCH, ABUF_B = KTILE_B + VTILE_B;

template <bool MASKED>
__device__ __forceinline__ void stick_half(f32x16& p, const int d, float& R, const int hi) {
    float lk[16];
#pragma unroll
    for (int r = 0; r < 16; ++r) { const float z = p[r]; const float e = __builtin_amdgcn_exp2f(-fabsf(z)); const float sp = relu_i(z) + __builtin_amdgcn_logf(1.0f + e);
        if (MASKED) { const bool valid = ((r & 3) + 8 * (r >> 2)) < d; lk[r] = valid ? -sp : 0.f; p[r] = valid ? z - sp : -__builtin_inff(); }
        else { lk[r] = -sp; p[r] = z - sp; } }
    float Gs[4], Ps[4], Tt[4];
#pragma unroll
    for (int g = 0; g < 4; ++g) { Gs[g] = (lk[4 * g] + lk[4 * g + 1]) + (lk[4 * g + 2] + lk[4 * g + 3]); Ps[g] = xor32_get(Gs[g], hi); Tt[g] = Gs[g] + Ps[g]; }
    float later[4];
    later[3] = 0.f; later[2] = Tt[3]; later[1] = Tt[3] + Tt[2]; later[0] = later[1] + Tt[1];
#pragma unroll
    for (int g = 0; g < 4; ++g) { const float base = R + later[g] + (hi == 0 ? Ps[g] : 0.f);
        const float e2 = lk[4 * g + 3], e1 = e2 + lk[4 * g + 2], e0 = e1 + lk[4 * g + 1];
        p[4 * g + 3] = __builtin_amdgcn_exp2f(p[4 * g + 3] + base); p[4 * g + 2] = __builtin_amdgcn_exp2f(p[4 * g + 2] + base + e2);
        p[4 * g + 1] = __builtin_amdgcn_exp2f(p[4 * g + 1] + base + e1); p[4 * g] = __builtin_amdgcn_exp2f(p[4 * g] + base + e0); }
    R += (Tt[0] + Tt[1]) + (Tt[2] + Tt[3]);
}

template <bool STICK>
__device__ __forceinline__ void attn_unit(LAS unsigned char* lds, const bf16_t* Qw, const bf16_t* Kg, int kpitch, const bf16_t* Vtg, const unsigned long long* MBrow,
                                          const bf16_t* SGw, bf16_t* Ow, int tq, int tmax_wave, int ntiles, int tid, int lane) {
    const int l31 = lane & 31, hi = lane >> 5;
    bf16x8 qf[8];
#pragma unroll
    for (int kk = 0; kk < 8; ++kk) qf[kk] = *(const GAS bf16x8*)(Qw + (size_t)l31 * DM + kk * 16 + hi * 8);
    f32x16 o[4];
#pragma unroll
    for (int dc = 0; dc < 4; ++dc) o[dc] = (f32x16){};
    float mrun = -__builtin_inff(), lsum = 0.f, R = 0.f;
    const int kr0 = tid >> 4, kc0 = tid & 15;
    const int vd0 = tid >> 3, vc0 = tid & 7;
    const int vco = (vc0 >> 1) * 32 + (vc0 & 1) * 8;
    u32x4 kreg[2], vreg[2];
#define ATT_LOAD(kt) do { const int key0_ = (kt) * 64; \
        kreg[0] = *(const GAS u32x4*)(Kg + (size_t)(key0_ + kr0) * kpitch + kc0 * 8); kreg[1] = *(const GAS u32x4*)(Kg + (size_t)(key0_ + kr0 + 32) * kpitch + kc0 * 8); \
        vreg[0] = *(const GAS u32x4*)(Vtg + (size_t)vd0 * T + key0_ + vc0 * 8); vreg[1] = *(const GAS u32x4*)(Vtg + (size_t)(vd0 + 64) * T + key0_ + vc0 * 8); } while (0)
#define ATT_STORE(buf) do { LAS unsigned char* kb_ = lds + (buf) * ABUF_B; LAS unsigned char* vb_ = kb_ + KTILE_B; \
        *(LAS u32x4*)(kb_ + kr0 * KPITCH + kc0 * 16) = kreg[0]; *(LAS u32x4*)(kb_ + (kr0 + 32) * KPITCH + kc0 * 16) = kreg[1]; \
        *(LAS u32x2*)(vb_ + vd0 * VPITCH + vco) = (u32x2){vreg[0].x, vreg[0].y}; *(LAS u32x2*)(vb_ + vd0 * VPITCH + vco + 16) = (u32x2){vreg[0].z, vreg[0].w}; \
        *(LAS u32x2*)(vb_ + (vd0 + 64) * VPITCH + vco) = (u32x2){vreg[1].x, vreg[1].y}; *(LAS u32x2*)(vb_ + (vd0 + 64) * VPITCH + vco + 16) = (u32x2){vreg[1].z, vreg[1].w}; } while (0)
#pragma unroll
    for (int kk = 0; kk < 8; ++kk) asm volatile("" :: "v"(qf[kk]));
    unsigned long long mb_next = 0ull;
    if (!STICK) mb_next = ((const GAS unsigned long long*)MBrow)[0];
    ATT_LOAD(STICK ? ntiles - 1 : 0);
    ATT_STORE(0);
    __syncthreads();
    for (int it = 0; it < ntiles; ++it) {
        const int kt = STICK ? ntiles - 1 - it : it;
        const int key0 = kt * 64;
        const unsigned long long mb = mb_next;
        if (!STICK && it + 1 < ntiles) mb_next = ((const GAS unsigned long long*)MBrow)[kt + 1];
        if (it + 1 < ntiles) ATT_LOAD(STICK ? kt - 1 : kt + 1);
        const LAS unsigned char* kb = lds + (it & 1) * ABUF_B; const LAS unsigned char* vb = kb + KTILE_B;
        const bool active = STICK ? (key0 < tmax_wave && !__all(R < -151.0f)) : true;
        if (active) {
            f32x16 p0 = {}, p1 = {};
            if (!STICK) {
                const unsigned nlo = ~((unsigned)mb >> (4 * hi)), nhi = ~((unsigned)(mb >> 32) >> (4 * hi));
#pragma unroll
                for (int r = 0; r < 16; ++r) { const int bp = (r & 3) + 8 * (r >> 2);
                    p0[r] = __int_as_float(sbfe1(nlo, bp) & (int)0xFF800000); p1[r] = __int_as_float(sbfe1(nhi, bp) & (int)0xFF800000); }
            }
#pragma unroll
            for (int kh = 0; kh < 2; ++kh) {
                bf16x8 kfa[4], kfb[4];
#pragma unroll
                for (int k4 = 0; k4 < 4; ++k4) { const int kk = kh * 4 + k4; kfa[k4] = *(const LAS bf16x8*)(kb + l31 * KPITCH + kk * 32 + hi * 16); kfb[k4] = *(const LAS bf16x8*)(kb + (32 + l31) * KPITCH + kk * 32 + hi * 16); }
                __builtin_amdgcn_sched_barrier(0);
                __builtin_amdgcn_s_setprio(1);
#pragma unroll
                for (int k4 = 0; k4 < 4; ++k4) { const int kk = kh * 4 + k4; p0 = __builtin_amdgcn_mfma_f32_32x32x16_bf16(kfa[k4], qf[kk], p0, 0, 0, 0); p1 = __builtin_amdgcn_mfma_f32_32x32x16_bf16(kfb[k4], qf[kk], p1, 0, 0, 0); }
                __builtin_amdgcn_s_setprio(0);
                __builtin_amdgcn_sched_barrier(0);
            }
            if (!STICK) {
                const float NEG = -__builtin_inff();
                float mx = NEG;
#pragma unroll
                for (int r = 0; r < 16; ++r) mx = max3f(mx, p0[r], p1[r]);
                mx = xor32_max(mx);
                const float mnew = fmaxf(mrun, mx);
                const float msafe = (mnew == NEG) ? 0.f : mnew;
                const float alpha = __builtin_amdgcn_exp2f(mrun - msafe);
                float ps = 0.f;
#pragma unroll
                for (int r = 0; r < 16; ++r) { p0[r] = __builtin_amdgcn_exp2f(p0[r] - msafe); p1[r] = __builtin_amdgcn_exp2f(p1[r] - msafe); ps += p0[r] + p1[r]; }
                lsum = lsum * alpha + ps;
                mrun = mnew;
                if (!__all(alpha == 1.0f)) {
#pragma unroll
                    for (int dc = 0; dc < 4; ++dc)
#pragma unroll
                        for (int r = 0; r < 16; ++r) o[dc][r] *= alpha;
                }
            } else {
#pragma unroll
                for (int h32 = 1; h32 >= 0; --h32) stick_half<true>(h32 ? p1 : p0, tq - (key0 + 32 * h32 + 4 * hi), R, hi);
            }
            bf16x8 pf[4];
#pragma unroll
            for (int j = 0; j < 4; ++j) { const f32x16& p = (j >> 1) ? p1 : p0; const int r0 = 8 * (j & 1);
                u32x4 w; w.x = cvt_pk_bf16(p[r0], p[r0 + 1]); w.y = cvt_pk_bf16(p[r0 + 2], p[r0 + 3]); w.z = cvt_pk_bf16(p[r0 + 4], p[r0 + 5]); w.w = cvt_pk_bf16(p[r0 + 6], p[r0 + 7]);
                pf[j] = __builtin_bit_cast(bf16x8, w); }
#pragma unroll
            for (int j = 0; j < 4; ++j) {
                u32x4 vv[4];
#pragma unroll
                for (int dc = 0; dc < 4; ++dc) vv[dc] = *(const LAS u32x4*)(vb + (32 * dc + l31) * VPITCH + 32 * j + 16 * hi);
                __builtin_amdgcn_sched_barrier(0);
                __builtin_amdgcn_s_setprio(1);
#pragma unroll
                for (int dc = 0; dc < 4; ++dc) o[dc] = __builtin_amdgcn_mfma_f32_32x32x16_bf16(__builtin_bit_cast(bf16x8, vv[dc]), pf[j], o[dc], 0, 0, 0);
                __builtin_amdgcn_s_setprio(0);
                __builtin_amdgcn_sched_barrier(0);
            }
        }
        if (it + 1 < ntiles) ATT_STORE((it + 1) & 1);
        if (STICK) {
            const int allneg = __all(R < -151.0f);
            if (lane == 0) ((volatile LAS int*)(lds + 2 * ABUF_B))[(it & 1) * 8 + (tid >> 6)] = allneg;
        }
        __syncthreads();
        if (STICK) {
            const volatile LAS int* fl = (const volatile LAS int*)(lds + 2 * ABUF_B) + (it & 1) * 8;
            int done = fl[0] & fl[1] & fl[2] & fl[3] & fl[4] & fl[5] & fl[6] & fl[7];
            if (done) break;
        }
    }
#undef ATT_LOAD
#undef ATT_STORE
    float inv = 1.0f;
    if (!STICK) { lsum = xor32_sum(lsum); inv = 1.0f / lsum; }
    u32x2 sgv[16];
#pragma unroll
    for (int i = 0; i < 16; ++i) sgv[i] = *(const GAS u32x2*)(SGw + (size_t)l31 * DM + 32 * (i >> 2) + 8 * (i & 3) + 4 * hi);
#pragma unroll
    for (int dc = 0; dc < 4; ++dc)
#pragma unroll
        for (int g = 0; g < 4; ++g) {
            const size_t off = (size_t)l31 * DM + 32 * dc + 8 * g + 4 * hi;
            const u32x2 sg = sgv[dc * 4 + g];
            u32x2 w;
            w.x = cvt_pk_bf16(o[dc][4 * g] * inv * bf_lo(sg.x), o[dc][4 * g + 1] * inv * bf_hi(sg.x));
            w.y = cvt_pk_bf16(o[dc][4 * g + 2] * inv * bf_lo(sg.y), o[dc][4 * g + 3] * inv * bf_hi(sg.y));
            *(GAS u32x2*)(Ow + off) = w;
        }
}

__device__ __forceinline__ void attn_unit_a(LAS unsigned char* lds, const bf16_t* Qw, const bf16_t* Kg, int kpitch, const bf16_t* Vtg, const unsigned long long* MBrow,
                                            const bf16_t* SGw, bf16_t* Ow, int ntiles, int tid, int lane) {
    const int l31 = lane & 31, hi = lane >> 5;
    const bool lag = tid >= 256;
    bf16x8 qf[8];
#pragma unroll
    for (int kk = 0; kk < 8; ++kk) qf[kk] = *(const GAS bf16x8*)(Qw + (size_t)l31 * DM + kk * 16 + hi * 8);
    f32x16 o[4];
#pragma unroll
    for (int dc = 0; dc < 4; ++dc) o[dc] = (f32x16){};
    float mrun = -__builtin_inff(), lsum = 0.f;
    const int kr0 = tid >> 4, kc0 = tid & 15, vd0 = tid >> 3, vc0 = tid & 7, vco = (vc0 >> 1) * 32 + (vc0 & 1) * 8;
    u32x4 kregA[2], vregA[2], kregB[2], vregB[2];
#define ATA_LOAD(kreg, vreg, kt) do { const int key0_ = (kt) * 64; \
        kreg[0] = *(const GAS u32x4*)(Kg + (size_t)(key0_ + kr0) * kpitch + kc0 * 8); kreg[1] = *(const GAS u32x4*)(Kg + (size_t)(key0_ + kr0 + 32) * kpitch + kc0 * 8); \
        vreg[0] = *(const GAS u32x4*)(Vtg + (size_t)vd0 * T + key0_ + vc0 * 8); vreg[1] = *(const GAS u32x4*)(Vtg + (size_t)(vd0 + 64) * T + key0_ + vc0 * 8); } while (0)
#define ATA_STORE(kreg, vreg, buf) do { LAS unsigned char* kb_ = lds + (buf) * ABUF_B; LAS unsigned char* vb_ = kb_ + KTILE_B; \
        *(LAS u32x4*)(kb_ + kr0 * KPITCH + kc0 * 16) = kreg[0]; *(LAS u32x4*)(kb_ + (kr0 + 32) * KPITCH + kc0 * 16) = kreg[1]; \
        *(LAS u32x2*)(vb_ + vd0 * VPITCH + vco) = (u32x2){vreg[0].x, vreg[0].y}; *(LAS u32x2*)(vb_ + vd0 * VPITCH + vco + 16) = (u32x2){vreg[0].z, vreg[0].w}; \
        *(LAS u32x2*)(vb_ + (vd0 + 64) * VPITCH + vco) = (u32x2){vreg[1].x, vreg[1].y}; *(LAS u32x2*)(vb_ + (vd0 + 64) * VPITCH + vco + 16) = (u32x2){vreg[1].z, vreg[1].w}; } while (0)
    f32x16 p0 = {}, p1 = {};
#define ATA_QK(kb, mb) do { \
        const unsigned nlo = ~((unsigned)(mb) >> (4 * hi)), nhi = ~((unsigned)((mb) >> 32) >> (4 * hi)); \
        _Pragma("unroll") for (int r = 0; r < 16; ++r) { const int bp = (r & 3) + 8 * (r >> 2); \
            p0[r] = __int_as_float(sbfe1(nlo, bp) & (int)0xFF800000); p1[r] = __int_as_float(sbfe1(nhi, bp) & (int)0xFF800000); } \
        _Pragma("unroll") for (int kh = 0; kh < 2; ++kh) { bf16x8 kfa[4], kfb[4]; \
            _Pragma("unroll") for (int k4 = 0; k4 < 4; ++k4) { const int kk = kh * 4 + k4; kfa[k4] = *(const LAS bf16x8*)((kb) + l31 * KPITCH + kk * 32 + hi * 16); kfb[k4] = *(const LAS bf16x8*)((kb) + (32 + l31) * KPITCH + kk * 32 + hi * 16); } \
            __builtin_amdgcn_sched_barrier(0); __builtin_amdgcn_s_setprio(1); \
            _Pragma("unroll") for (int k4 = 0; k4 < 4; ++k4) { const int kk = kh * 4 + k4; p0 = __builtin_amdgcn_mfma_f32_32x32x16_bf16(kfa[k4], qf[kk], p0, 0, 0, 0); p1 = __builtin_amdgcn_mfma_f32_32x32x16_bf16(kfb[k4], qf[kk], p1, 0, 0, 0); } \
            __builtin_amdgcn_s_setprio(0); __builtin_amdgcn_sched_barrier(0); } } while (0)
#define ATA_SMPV(vb) do { \
        const float NEG = -__builtin_inff(); float mx = NEG; \
        _Pragma("unroll") for (int r = 0; r < 16; ++r) mx = max3f(mx, p0[r], p1[r]); \
        mx = xor32_max(mx); \
        const float mnew = fmaxf(mrun, mx); const float msafe = (mnew == NEG) ? 0.f : mnew; const float alpha = __builtin_amdgcn_exp2f(mrun - msafe); \
        float ps = 0.f; \
        _Pragma("unroll") for (int r = 0; r < 16; ++r) { p0[r] = __builtin_amdgcn_exp2f(p0[r] - msafe); p1[r] = __builtin_amdgcn_exp2f(p1[r] - msafe); ps += p0[r] + p1[r]; } \
        lsum = lsum * alpha + ps; mrun = mnew; \
        if (!__all(alpha == 1.0f)) { _Pragma("unroll") for (int dc = 0; dc < 4; ++dc) _Pragma("unroll") for (int r = 0; r < 16; ++r) o[dc][r] *= alpha; } \
        bf16x8 pf[4]; \
        _Pragma("unroll") for (int j = 0; j < 4; ++j) { const f32x16& p = (j >> 1) ? p1 : p0; const int r0 = 8 * (j & 1); \
            u32x4 w; w.x = cvt_pk_bf16(p[r0], p[r0 + 1]); w.y = cvt_pk_bf16(p[r0 + 2], p[r0 + 3]); w.z = cvt_pk_bf16(p[r0 + 4], p[r0 + 5]); w.w = cvt_pk_bf16(p[r0 + 6], p[r0 + 7]); \
            pf[j] = __builtin_bit_cast(bf16x8, w); } \
        _Pragma("unroll") for (int j = 0; j < 4; ++j) { u32x4 vv[4]; \
            _Pragma("unroll") for (int dc = 0; dc < 4; ++dc) vv[dc] = *(const LAS u32x4*)((vb) + (32 * dc + l31) * VPITCH + 32 * j + 16 * hi); \
            __builtin_amdgcn_sched_barrier(0); __builtin_amdgcn_s_setprio(1); \
            _Pragma("unroll") for (int dc = 0; dc < 4; ++dc) o[dc] = __builtin_amdgcn_mfma_f32_32x32x16_bf16(__builtin_bit_cast(bf16x8, vv[dc]), pf[j], o[dc], 0, 0, 0); \
            __builtin_amdgcn_s_setprio(0); __builtin_amdgcn_sched_barrier(0); } } while (0)
#pragma unroll
    for (int kk = 0; kk < 8; ++kk) asm volatile("" :: "v"(qf[kk]));
    unsigned long long mb_next = ((const GAS unsigned long long*)MBrow)[0];
    ATA_LOAD(kregA, vregA, 0);
    ATA_STORE(kregA, vregA, 0);
    if (ntiles > 1) ATA_LOAD(kregA, vregA, 1);
    __syncthreads();
    int b_prev = 2, b_cur = 0, b_next = 1;
#define ATA_STEP(t, kL, vL, kS, vS) do { \
        const unsigned long long mb = mb_next; \
        if ((t) + 1 < ntiles) mb_next = ((const GAS unsigned long long*)MBrow)[(t) + 1]; \
        if ((t) + 2 < ntiles) ATA_LOAD(kL, vL, (t) + 2); \
        const LAS unsigned char* kb = lds + b_cur * ABUF_B; \
        if (!lag) { ATA_QK(kb, mb); ATA_SMPV(kb + KTILE_B); } \
        else { if ((t) > 0) ATA_SMPV(lds + b_prev * ABUF_B + KTILE_B); ATA_QK(kb, mb); } \
        if ((t) + 1 < ntiles) ATA_STORE(kS, vS, b_next); \
        __syncthreads(); \
        b_prev = b_cur; b_cur = b_next; b_next = (b_next == 2) ? 0 : b_next + 1; } while (0)
    for (int it = 0; it < ntiles; it += 2) {
        ATA_STEP(it, kregB, vregB, kregA, vregA);
        if (it + 1 < ntiles) ATA_STEP(it + 1, kregA, vregA, kregB, vregB);
    }
#undef ATA_STEP
    if (lag) ATA_SMPV(lds + b_prev * ABUF_B + KTILE_B);
#undef ATA_LOAD
#undef ATA_STORE
#undef ATA_QK
#undef ATA_SMPV
    lsum = xor32_sum(lsum);
    const float inv = 1.0f / lsum;
    u32x2 sgv[16];
#pragma unroll
    for (int i = 0; i < 16; ++i) sgv[i] = *(const GAS u32x2*)(SGw + (size_t)l31 * DM + 32 * (i >> 2) + 8 * (i & 3) + 4 * hi);
#pragma unroll
    for (int dc = 0; dc < 4; ++dc)
#pragma unroll
        for (int g = 0; g < 4; ++g) {
            const size_t off = (size_t)l31 * DM + 32 * dc + 8 * g + 4 * hi;
            const u32x2 sg = sgv[dc * 4 + g];
            u32x2 w;
            w.x = cvt_pk_bf16(o[dc][4 * g] * inv * bf_lo(sg.x), o[dc][4 * g + 1] * inv * bf_hi(sg.x));
            w.y = cvt_pk_bf16(o[dc][4 * g + 2] * inv * bf_lo(sg.y), o[dc][4 * g + 3] * inv * bf_hi(sg.y));
            *(GAS u32x2*)(Ow + off) = w;
        }
    __syncthreads();
}

__device__ __forceinline__ int vcu_of(int bx, int G) { return (G % 8 == 0) ? (bx % 8) * (G / 8) + bx / 8 : bx; }

__device__ __forceinline__ void attn_a_phase(const Args& a, LAS unsigned char* lds, int bx, int G, int tid, int wave, int lane) {
    const int v = vcu_of(bx, G);
    bf16_t* QO = (bf16_t*)(a.ws + WS_QO); const bf16_t* KA = (const bf16_t*)(a.ws + WS_KA); const bf16_t* VTA = (const bf16_t*)(a.ws + WS_VTA);
    const bf16_t* SG = (const bf16_t*)(a.ws + WS_SGP); const unsigned long long* MB = (const unsigned long long*)(a.ws + WS_MB);
    for (int L = v; L < 2048; L += G) {
        const int i = L >> 8, c = L & 255;
        const int bk = (c >> 5) + 8 * i, b = bk >> 2, kvh = bk & 3;
        const int qb = (i & 1) ? 31 - (c & 31) : (c & 31);
        const int head = kvh * 4 + (wave >> 1);
        const int trow = qb * 64 + (wave & 1) * 32;
        const size_t tok0 = (size_t)b * SEQ + trow;
        bf16_t* Qw = QO + tok0 * DM + head * HD;
        attn_unit_a(lds, Qw, KA + (size_t)b * SEQ * 512 + kvh * HD, 512, VTA + (size_t)(kvh * HD) * T + (size_t)b * SEQ,
                    MB + (tok0 + (lane & 31)) * 32, SG + tok0 * DM + head * HD, (bf16_t*)(a.ws + WS_XB1) + tok0 * DM + head * HD, qb + 1, tid, lane);
    }
}
__device__ __forceinline__ void attn_b_phase(const Args& a, LAS unsigned char* lds, int bx, int G, int tid, int wave, int lane) {
    const int v = vcu_of(bx, G);
    bf16_t* QO = (bf16_t*)(a.ws + WS_QO); const bf16_t* KB = (const bf16_t*)(a.ws + WS_KB); const bf16_t* VTB = (const bf16_t*)(a.ws + WS_VTB);
    const bf16_t* SG = (const bf16_t*)(a.ws + WS_SGP);
    for (int L = v; L < 2048; L += G) {
        const int i = L >> 8, c = L & 255;
        const int bh = (c >> 3) + 32 * i, b = bh >> 4, h = bh & 15;
        const int qb = (i & 1) ? 7 - (c & 7) : (c & 7);
        const int trow = qb * 256 + wave * 32;
        const size_t tok0 = (size_t)b * SEQ + trow;
        bf16_t* Qw = QO + tok0 * DM + h * HD;
        attn_unit<true>(lds, Qw, KB + (size_t)b * SEQ * DM + h * HD, DM, VTB + (size_t)(h * HD) * T + (size_t)b * SEQ,
                        nullptr, SG + tok0 * DM + h * HD, (bf16_t*)(a.ws + WS_XB1) + tok0 * DM + h * HD, trow + (lane & 31), trow + 31, 4 * qb + 4, tid, lane);
    }
}

constexpr int NPHASES = 19;
enum { K_PRO = 0, K_INA, K_IDX, K_ATA, K_OUT, K_GATE, K_QGB, K_ATB };

__global__ void __launch_bounds__(NTHREADS, 2) fwd_megakernel(Args a0) {
    extern __shared__ __attribute__((aligned(16))) unsigned char lds_raw[];
    LAS unsigned char* lds = (LAS unsigned char*)lds_raw;
    const int ph_lo = a0.ph_lo, ph_hi = a0.ph_hi;
    const int wave0 = __builtin_amdgcn_readfirstlane(threadIdx.x >> 6);
    if (threadIdx.x == 0) { ((volatile LAS unsigned*)(lds + LDS_BARST))[0] = 0u; ((volatile LAS unsigned*)(lds + LDS_BARST))[1] = 0u; }
    __syncthreads();
    for (int ph = ph_lo; ph < ph_hi; ++ph) {
        int kind, layer;
        if (ph == 0) { kind = K_PRO; layer = 0; }
        else if (ph < 11) { layer = (ph - 1) / 5; const int s = (ph - 1) % 5; kind = s == 0 ? K_INA : s == 1 ? K_IDX : s == 2 ? K_ATA : s == 3 ? K_OUT : K_GATE; }
        else { layer = 2 + (ph - 11) / 4; const int s = (ph - 11) % 4; kind = s == 0 ? K_QGB : s == 1 ? K_ATB : s == 2 ? K_OUT : K_GATE; }
        const int reps = (kind == PROBE_REPEAT_KIND) ? 2 : 1;
        for (int rep = 0; rep < reps; ++rep) {
        if (rep) xcd_barrier((unsigned*)(a0.ws + WS_BAR), (volatile LAS unsigned*)(lds + LDS_BARST), (int)threadIdx.x, gridDim.x);
        int lane; asm volatile("v_mbcnt_lo_u32_b32 %0, -1, 0\n\tv_mbcnt_hi_u32_b32 %0, -1, %0" : "=v"(lane));
        int wave = wave0; asm volatile("" : "+s"(wave));
        const int tid = wave * 64 + lane;
        int bx = blockIdx.x, G = gridDim.x; asm volatile("" : "+s"(bx), "+s"(G));
        Args a = a0;
        asm volatile("" : "+s"(a.out), "+s"(a.ws));
        unsigned char* ws = a.ws;
        if (kind == K_PRO) {
#ifndef NO_PRO
            asm volatile("" : "+s"(a.x), "+s"(a.p), "+s"(a.pos), "+s"(a.w_in_a), "+s"(a.w_out_a), "+s"(a.w_q_b), "+s"(a.w_kv_b));
            asm volatile("" : "+s"(a.w_out_b), "+s"(a.w_ple), "+s"(a.w_ple_gate), "+s"(a.ln_g), "+s"(a.ln_b));
            prologue(a, lds, bx, G, tid, wave, lane);
#endif
        } else if (kind == K_IDX) {
#ifndef NO_IDX
            indexer_phase(a, lds, bx, G, wave, lane);
#endif
        } else if (kind == K_ATA) {
#ifndef NO_ATA
            attn_a_phase(a, lds, bx, G, tid, wave, lane);
#endif
        } else if (kind == K_ATB) {
#ifndef NO_ATB
            attn_b_phase(a, lds, bx, G, tid, wave, lane);
#endif
        } else {
#ifndef NO_GEMM
            if (kind == K_INA && layer == 0) {
                const GAS float* gp = (const GAS float*)(ws + WS_GPART); GAS float* lnp = (GAS float*)(ws + WS_LNP);
                for (int i = bx * NTHREADS + tid; i < 4 * 2 * DM; i += G * NTHREADS) { const int c = i & 2047, which = (i >> 11) & 1, l = i >> 12; float sum = 0.f;
#pragma unroll
                    for (int ks = 0; ks < 16; ++ks) sum += gp[((size_t)(ks * 4 + l) * 2 + which) * DM + c];
                    lnp[(size_t)l * 4 * DM + (2 + which) * DM + c] = sum; }
            }
            const int njobs = (kind == K_INA || kind == K_OUT) ? 2 : (kind == K_QGB && layer == 2) ? 3 : 1;
            for (int j = 0; j < njobs; ++j) {
                pg8::Gemm g; pg8::Epi E; E.ws = ws; E.xin = nullptr; E.xf = a.out; E.O = nullptr; E.ldc = 0; E.ymul = 1.0f; E.mode = pg8::MODE_PLAIN; E.layer = layer;
                const bf16_t* xb2 = (const bf16_t*)(ws + WS_XB2);
                if (kind == K_INA) {
                    const bf16_t* W = (const bf16_t*)(ws + WS_WINA) + (size_t)layer * AWP * DM;
                    if (j == 0) { g = pg8::Gemm{xb2, W, T, ANP, DM}; E.mode = pg8::MODE_INA; }
                    else { g = pg8::Gemm{W + (size_t)ANP * DM, xb2, 512, T, DM}; E.O = (bf16_t*)(ws + WS_VTA); E.ldc = T; }
                } else if (kind == K_OUT) {
                    if (j == 0) { const bf16_t* W = layer < 2 ? (const bf16_t*)(ws + WS_WOUTA) + (size_t)layer * DM * DM : (const bf16_t*)(ws + WS_WOUTB) + (size_t)(layer - 2) * DM * DM;
                        g = pg8::Gemm{(const bf16_t*)(ws + WS_XB1), W, T, DM, DM}; E.mode = pg8::MODE_OUT; const float* xin0 = a.x; asm volatile("" : "+s"(xin0)); E.xin = layer == 0 ? xin0 : a.out; E.ymul = layer < 2 ? DBG_YMUL_A : DBG_YMUL_B; }
                    else { g = pg8::Gemm{(const bf16_t*)(ws + WS_PBF), (const bf16_t*)(ws + WS_WPLE) + (size_t)layer * DM * PLE, T, DM, PLE}; E.O = (bf16_t*)(ws + WS_SGP); E.ldc = DM; }
                } else if (kind == K_GATE) {
                    g = pg8::Gemm{(const bf16_t*)(ws + WS_QO), (const bf16_t*)(ws + WS_WG) + (size_t)layer * DM * DM, T, DM, DM}; E.mode = pg8::MODE_GATE;
                } else {
                    const bf16_t* Wkv = (const bf16_t*)(ws + WS_WKV);
                    if (j == 0) { g = pg8::Gemm{xb2, (const bf16_t*)(ws + WS_WQB) + (size_t)(layer - 2) * 4096 * DM, T, 4096, DM}; E.mode = pg8::MODE_QG; }
                    else if (j == 1) { g = pg8::Gemm{xb2, Wkv, T, DM, DM}; E.O = (bf16_t*)(ws + WS_KB); E.ldc = DM; }
                    else { g = pg8::Gemm{Wkv + (size_t)DM * DM, xb2, DM, T, DM}; E.O = (bf16_t*)(ws + WS_VTB); E.ldc = T; }
                }
                pg8::StaticOrder S; S.init(g.M, g.N, G, bx);
#define RUN_GEMM(M) { pg8::EpiT<M> EE; static_cast<pg8::Epi&>(EE) = E; pg8::gemm_phase<pg8::EpiT<M>, pg8::StaticOrder>(lds, g, S, EE, wave); }
                if (E.mode == pg8::MODE_PLAIN) RUN_GEMM(pg8::MODE_PLAIN)
                else if (E.mode == pg8::MODE_INA) RUN_GEMM(pg8::MODE_INA)
                else if (E.mode == pg8::MODE_QG) RUN_GEMM(pg8::MODE_QG)
                else if (E.mode == pg8::MODE_OUT) RUN_GEMM(pg8::MODE_OUT)
                else RUN_GEMM(pg8::MODE_GATE)
#undef RUN_GEMM
            }
            if (kind == K_GATE && layer + 1 < 4) {
                const float* pp = a.p; asm volatile("" : "+s"(pp));
                int lane2; asm volatile("v_mbcnt_lo_u32_b32 %0, -1, 0\n\tv_mbcnt_hi_u32_b32 %0, -1, %0" : "=v"(lane2));
                cvt_rows(pp + (size_t)(layer + 1) * T * PLE, (bf16_t*)(ws + WS_PBF), (size_t)T * PLE / 8, (size_t)bx * NTHREADS + wave * 64 + lane2, (size_t)G * NTHREADS);
            }
#endif
        }
        }
        if (ph + 1 < ph_hi) {
            if (ph == 0) { cg::this_grid().sync(); if (threadIdx.x == 0) (void)xb_add((unsigned*)(a0.ws + WS_BAR) + XB_XCNT(xb_xcc_id()), 1u); }
            else xcd_barrier((unsigned*)(a0.ws + WS_BAR), (volatile LAS unsigned*)(lds + LDS_BARST), (int)threadIdx.x, gridDim.x);
            for (int e = 0; ph == 1 && e < PROBE_EXTRA_SYNCS; ++e) xcd_barrier((unsigned*)(a0.ws + WS_BAR), (volatile LAS unsigned*)(lds + LDS_BARST), (int)threadIdx.x, gridDim.x);
        }
    }
}

extern "C" void kernel_launch(void* const* d_in, const int* in_sizes, int n_in, void* d_out, int out_size, void* d_ws, size_t ws_size, hipStream_t stream) {
    static int grid = 0;
    if (grid == 0) {
        if (n_in != 12 || out_size != T * DM || ws_size < WS_END) { fprintf(stderr, "kernel_launch: unexpected shapes (n_in %d out %d ws %zu); nothing launched\n", n_in, out_size, ws_size); grid = -1; return; }
        int dev = 0, cus = 0, per_cu = 0;
        if (hipGetDevice(&dev) != hipSuccess || hipDeviceGetAttribute(&cus, hipDeviceAttributeMultiprocessorCount, dev) != hipSuccess) { grid = -1; return; }
        if (hipFuncSetAttribute((const void*)fwd_megakernel, hipFuncAttributeMaxDynamicSharedMemorySize, LDS_BYTES) != hipSuccess) { fprintf(stderr, "kernel_launch: hipFuncSetAttribute failed\n"); grid = -1; return; }
        if (hipOccupancyMaxActiveBlocksPerMultiprocessor(&per_cu, (const void*)fwd_megakernel, NTHREADS, LDS_BYTES) != hipSuccess || per_cu < 1) { fprintf(stderr, "kernel_launch: occupancy query says %d\n", per_cu); per_cu = 1; }
        (void)hipGetLastError();
        grid = cus * 1;
    }
    if (grid < 0) return;
    Args a{};
    a.x = (const float*)d_in[0]; a.p = (const float*)d_in[1]; a.pos = (const int*)d_in[2]; a.w_in_a = (const float*)d_in[3]; a.w_out_a = (const float*)d_in[4];
    a.w_q_b = (const float*)d_in[5]; a.w_kv_b = (const float*)d_in[6]; a.w_out_b = (const float*)d_in[7]; a.ln_g = (const float*)d_in[8]; a.ln_b = (const float*)d_in[9];
    a.w_ple = (const float*)d_in[10]; a.w_ple_gate = (const float*)d_in[11]; a.out = (float*)d_out; a.ws = (unsigned char*)d_ws; a.ph_lo = 0; a.ph_hi = NPHASES;
    void* args[] = {&a};
    hipError_t e = hipLaunchCooperativeKernel((const void*)fwd_megakernel, dim3(grid), dim3(NTHREADS), args, LDS_BYTES, stream);
    if (e != hipSuccess) fprintf(stderr, "kernel_launch: cooperative launch failed: %s (grid %d)\n", hipGetErrorString(e), grid);
}
```
